# Optimizing an MI355X kernel written in HIP

```python
import math
import jax, jax.numpy as jnp
from jax import lax
import numpy as np

D_MODEL = 1024
BATCH = 8
SEQ = 4096
DEPTH = 1

D_S5 = D_MODEL // 2
S5_GROUP = 16
S5_GROUPS = D_S5 // S5_GROUP
S5_STATE = 64
DT_MIN = 1e-3
DT_MAX = 1e-1
D_FOURIER = D_MODEL // 2
FOURIER_GROUPS = 4
FOURIER_WIDTH = D_FOURIER // FOURIER_GROUPS
N_BRANCHES = 2
W_IN = D_S5 + D_FOURIER + N_BRANCHES * D_MODEL
N_EXPERTS = 256
TOP_K = 8
N_EXPERT_GROUPS = 8
TOPK_GROUPS = 4
D_EXPERT = 256
D_SHARED = 256
ROUTED_SCALE = 2.5
EXPERT_BLOCK = 128
ALPHA = (2 * DEPTH) ** 0.25
BETA = (8 * DEPTH) ** -0.25
LN_EPS = 1e-5

kernel_name = 'hybrid_s5_fnet_moe_encoder_block'


def _standardize(x):
    xf = x.astype(jnp.float32)
    mu = jnp.mean(xf, axis=-1, keepdims=True)
    var = jnp.mean(jnp.square(xf - mu), axis=-1, keepdims=True)
    return (xf - mu) * lax.rsqrt(var + LN_EPS)


def _layer_norm(x, g, b):
    return (_standardize(x) * g.astype(jnp.float32) + b.astype(jnp.float32)).astype(x.dtype)


def _modulate(x, shift, scale):
    y = _standardize(x) * (1.0 + scale[:, None, :].astype(jnp.float32)) + shift[:, None, :].astype(jnp.float32)
    return y.astype(x.dtype)


def _diag_complex_combine(e1, e2):
    a1r, a1i, b1r, b1i = e1
    a2r, a2i, b2r, b2i = e2
    return (a2r * a1r - a2i * a1i,
            a2r * a1i + a2i * a1r,
            a2r * b1r - a2i * b1i + b2r,
            a2r * b1i + a2i * b1r + b2i)


def _s5_bidirectional(u, lam_re, lam_im, log_dt, b_re, b_im, c_re, c_im, d_skip):
    bsz, seq = u.shape[0], u.shape[1]
    f32 = jnp.float32
    u = u.astype(f32).reshape(bsz, seq, S5_GROUPS, S5_GROUP)
    y = d_skip.astype(f32).reshape(S5_GROUPS, S5_GROUP) * u
    for direction in range(2):
        lr = lam_re[direction].astype(f32)
        li = lam_im[direction].astype(f32)
        dt = jnp.exp(log_dt[direction].astype(f32))[:, None]
        mag = jnp.exp(lr * dt)
        ang = li * dt
        ab_re = mag * jnp.cos(ang)
        ab_im = mag * jnp.sin(ang)
        den = lr * lr + li * li
        nr = ab_re - 1.0
        coef_re = (nr * lr + ab_im * li) / den
        coef_im = (ab_im * lr - nr * li) / den
        br = b_re[direction].astype(f32)
        bi = b_im[direction].astype(f32)
        bb_re = coef_re[:, :, None] * br - coef_im[:, :, None] * bi
        bb_im = coef_re[:, :, None] * bi + coef_im[:, :, None] * br
        bu_re = jnp.einsum('bsgh,gph->sbgp', u, bb_re)
        bu_im = jnp.einsum('bsgh,gph->sbgp', u, bb_im)
        a_re = jnp.broadcast_to(ab_re, (seq, 1) + ab_re.shape)
        a_im = jnp.broadcast_to(ab_im, (seq, 1) + ab_im.shape)
        _, _, x_re, x_im = lax.associative_scan(
            _diag_complex_combine, (a_re, a_im, bu_re, bu_im), reverse=(direction == 1), axis=0)
        y = (y + jnp.einsum('ghp,sbgp->bsgh', c_re[direction].astype(f32), x_re)
               - jnp.einsum('ghp,sbgp->bsgh', c_im[direction].astype(f32), x_im))
    return y.reshape(bsz, seq, D_S5)


def _fourier_groups(u):
    bsz, seq = u.shape[0], u.shape[1]
    uf = u.astype(jnp.float32).reshape(bsz, seq, FOURIER_GROUPS, FOURIER_WIDTH)
    yf = jnp.real(jnp.fft.fft2(uf, axes=(1, 3), norm='ortho'))
    return yf.reshape(bsz, seq, D_FOURIER)


def _moe_ffn(h, w_router, router_bias, w_exp_gate, w_exp_up, w_exp_down, w_sh_gate, w_sh_up, w_sh_down):
    n_tok = h.shape[0]
    scores = jax.nn.sigmoid((h @ w_router).astype(jnp.float32))
    sel = scores + router_bias.astype(jnp.float32)
    grp = sel.reshape(n_tok, N_EXPERT_GROUPS, N_EXPERTS // N_EXPERT_GROUPS)
    grp_score = jnp.sum(lax.top_k(grp, 2)[0], axis=-1)
    _, gidx = lax.top_k(grp_score, TOPK_GROUPS)
    gmask = jnp.any(gidx[:, :, None] == jnp.arange(N_EXPERT_GROUPS)[None, None, :], axis=1)
    masked = jnp.where(gmask[:, :, None], grp, -jnp.inf).reshape(n_tok, N_EXPERTS)
    _, eidx = lax.top_k(masked, TOP_K)
    gate = jnp.take_along_axis(scores, eidx, axis=-1)
    gate = gate / jnp.sum(gate, axis=-1, keepdims=True) * ROUTED_SCALE

    n_assign = n_tok * TOP_K
    n_blocks = (n_assign + N_EXPERTS * (EXPERT_BLOCK - 1) + EXPERT_BLOCK - 1) // EXPERT_BLOCK
    n_rows = n_blocks * EXPERT_BLOCK
    e_flat = eidx.reshape(-1).astype(jnp.int32)
    w_flat = gate.reshape(-1)
    tok_flat = jnp.arange(n_assign, dtype=jnp.int32) // TOP_K
    order = jnp.argsort(e_flat)
    e_sorted = e_flat[order]
    counts = jnp.bincount(e_flat, length=N_EXPERTS).astype(jnp.int32)
    padded = ((counts + EXPERT_BLOCK - 1) // EXPERT_BLOCK) * EXPERT_BLOCK
    pend = jnp.cumsum(padded)
    pstart = pend - padded
    ustart = jnp.cumsum(counts) - counts
    dest = pstart[e_sorted] + (jnp.arange(n_assign, dtype=jnp.int32) - ustart[e_sorted])
    row_tok = jnp.zeros((n_rows,), jnp.int32).at[dest].set(tok_flat[order])
    row_w = jnp.zeros((n_rows,), jnp.float32).at[dest].set(w_flat[order])
    blk_start = jnp.arange(n_blocks, dtype=jnp.int32) * EXPERT_BLOCK
    blk_e = jnp.minimum(jnp.searchsorted(pend, blk_start, side='right'), N_EXPERTS - 1)

    def _expert_block(args):
        idx, e = args
        rows = h[idx]
        hid = jax.nn.silu(rows @ w_exp_gate[e]) * (rows @ w_exp_up[e])
        return hid @ w_exp_down[e]

    y_rows = lax.map(_expert_block, (row_tok.reshape(n_blocks, EXPERT_BLOCK), blk_e))
    y_rows = y_rows.reshape(n_rows, -1) * row_w.astype(h.dtype)[:, None]
    routed = jax.ops.segment_sum(y_rows, row_tok, num_segments=n_tok)
    shared = (jax.nn.silu(h @ w_sh_gate) * (h @ w_sh_up)) @ w_sh_down
    return shared + routed


def setup_inputs(seed: int = 0) -> dict:
    key = jax.random.key(seed)
    ks = jax.random.split(key, 32)
    L = DEPTH
    f32 = jnp.float32

    def nrm(k, shape, scale):
        return scale * jax.random.normal(k, shape, f32)

    lam_re = -0.5 + nrm(ks[6], (L, 2, S5_GROUPS, S5_STATE), 0.01)
    lam_im = jnp.pi * jnp.arange(S5_STATE, dtype=f32) + nrm(ks[7], (L, 2, S5_GROUPS, S5_STATE), 0.01)
    log_dt = jax.random.uniform(ks[8], (L, 2, S5_GROUPS), f32, math.log(DT_MIN), math.log(DT_MAX))
    return {
        'x': nrm(ks[0], (BATCH, SEQ, D_MODEL), 1.0),
        'c': nrm(ks[1], (BATCH, D_MODEL), 1.0),
        'w_ada': nrm(ks[2], (L, D_MODEL, 6 * D_MODEL), D_MODEL ** -0.5),
        'b_ada': nrm(ks[3], (L, 6 * D_MODEL), 0.01),
        'w_in': nrm(ks[4], (L, D_MODEL, W_IN), D_MODEL ** -0.5),
        'b_in': nrm(ks[5], (L, W_IN), 0.01),
        's5_lambda_re': lam_re,
        's5_lambda_im': lam_im,
        's5_log_dt': log_dt,
        's5_b_re': nrm(ks[9], (L, 2, S5_GROUPS, S5_STATE, S5_GROUP), (2 * S5_GROUP) ** -0.5),
        's5_b_im': nrm(ks[10], (L, 2, S5_GROUPS, S5_STATE, S5_GROUP), (2 * S5_GROUP) ** -0.5),
        's5_c_re': nrm(ks[11], (L, 2, S5_GROUPS, S5_GROUP, S5_STATE), S5_STATE ** -0.5),
        's5_c_im': nrm(ks[12], (L, 2, S5_GROUPS, S5_GROUP, S5_STATE), S5_STATE ** -0.5),
        's5_d': nrm(ks[13], (L, D_S5), 1.0),
        'w_s5_glu': nrm(ks[14], (L, D_S5, 2 * D_MODEL), D_S5 ** -0.5),
        'b_s5_glu': nrm(ks[15], (L, 2 * D_MODEL), 0.01),
        'w_fourier': nrm(ks[16], (L, D_FOURIER, D_MODEL), D_FOURIER ** -0.5),
        'b_fourier': nrm(ks[17], (L, D_MODEL), 0.01),
        'w_out': nrm(ks[18], (L, D_MODEL, D_MODEL), BETA * D_MODEL ** -0.5),
        'b_out': nrm(ks[19], (L, D_MODEL), 0.01),
        'ln1_g': 1.0 + nrm(ks[20], (L, D_MODEL), 0.01),
        'ln1_b': nrm(ks[21], (L, D_MODEL), 0.01),
        'w_router': nrm(ks[22], (L, D_MODEL, N_EXPERTS), D_MODEL ** -0.5),
        'router_bias': nrm(ks[23], (L, N_EXPERTS), 0.01),
        'w_exp_gate': nrm(ks[24], (L, N_EXPERTS, D_MODEL, D_EXPERT), D_MODEL ** -0.5),
        'w_exp_up': nrm(ks[25], (L, N_EXPERTS, D_MODEL, D_EXPERT), D_MODEL ** -0.5),
        'w_exp_down': nrm(ks[26], (L, N_EXPERTS, D_EXPERT, D_MODEL), BETA * D_EXPERT ** -0.5),
        'w_sh_gate': nrm(ks[27], (L, D_MODEL, D_SHARED), D_MODEL ** -0.5),
        'w_sh_up': nrm(ks[28], (L, D_MODEL, D_SHARED), D_MODEL ** -0.5),
        'w_sh_down': nrm(ks[29], (L, D_SHARED, D_MODEL), BETA * D_SHARED ** -0.5),
        'ln2_g': 1.0 + nrm(ks[30], (L, D_MODEL), 0.01),
        'ln2_b': nrm(ks[31], (L, D_MODEL), 0.01),
    }


def reference(x, c, w_ada, b_ada, w_in, b_in, s5_lambda_re, s5_lambda_im, s5_log_dt,
              s5_b_re, s5_b_im, s5_c_re, s5_c_im, s5_d, w_s5_glu, b_s5_glu,
              w_fourier, b_fourier, w_out, b_out, ln1_g, ln1_b,
              w_router, router_bias, w_exp_gate, w_exp_up, w_exp_down,
              w_sh_gate, w_sh_up, w_sh_down, ln2_g, ln2_b):
    bsz, seq, d = x.shape
    for l in range(DEPTH):
        mod = jax.nn.silu(c) @ w_ada[l] + b_ada[l]
        sh1, sc1, g1, sh2, sc2, g2 = jnp.split(mod, 6, axis=-1)

        u = _modulate(x, sh1, sc1)
        proj = u @ w_in[l] + b_in[l]
        u_s5 = proj[..., :D_S5]
        u_f = proj[..., D_S5:D_S5 + D_FOURIER]
        gate_pre = proj[..., D_S5 + D_FOURIER:]

        y_s5 = _s5_bidirectional(u_s5, s5_lambda_re[l], s5_lambda_im[l], s5_log_dt[l],
                                 s5_b_re[l], s5_b_im[l], s5_c_re[l], s5_c_im[l], s5_d[l]).astype(x.dtype)
        z = jax.nn.gelu(y_s5)
        glu = z @ w_s5_glu[l] + b_s5_glu[l]
        br_s5 = glu[..., :d] * jax.nn.sigmoid(glu[..., d:])

        br_f = _fourier_groups(u_f).astype(x.dtype) @ w_fourier[l] + b_fourier[l]

        gates = jax.nn.sigmoid(gate_pre)
        merged = gates[..., :d] * br_s5 + gates[..., d:] * br_f
        mix = merged @ w_out[l] + b_out[l]
        x = _layer_norm(ALPHA * x + g1[:, None, :] * mix, ln1_g[l], ln1_b[l])

        h = _modulate(x, sh2, sc2).reshape(bsz * seq, d)
        ffn = _moe_ffn(h, w_router[l], router_bias[l], w_exp_gate[l], w_exp_up[l], w_exp_down[l],
                       w_sh_gate[l], w_sh_up[l], w_sh_down[l]).reshape(bsz, seq, d)
        x = _layer_norm(ALPHA * x + g2[:, None, :] * ffn, ln2_g[l], ln2_b[l])
    return x
```

```cpp
#include <hip/hip_runtime.h>
#include <cstdio>
#include <cstdint>

#ifndef PG_SP2
#define PG_SP2 true
#define PG_ALIGN true
#endif
#ifndef P13_NT2
#define P13_NT2 0
#endif
#ifndef MK_N_LAUNCHES
#define MK_N_LAUNCHES 1
#endif

#define LAS __attribute__((address_space(3)))
#define GAS __attribute__((address_space(1)))
typedef unsigned short bf16_t;
typedef short bf16x8 __attribute__((ext_vector_type(8)));
typedef float f32x4 __attribute__((ext_vector_type(4)));
typedef unsigned u32x4 __attribute__((ext_vector_type(4)));
typedef unsigned u32x2 __attribute__((ext_vector_type(2)));

constexpr int NB = 8, SEQ = 4096, DM = 1024, TOK = NB * SEQ;
constexpr int NEXP = 256, TOPK = 8, DEXP = 256;
constexpr int NGRP = 32;
constexpr float ALPHA = 1.189207115002721f;
constexpr float LN_EPS = 1e-5f;
constexpr int MAXROWS = TOK * TOPK + NEXP * 256;
constexpr int SH_TILE0 = MAXROWS / 256;

constexpr size_t MiB = 1u << 20;
constexpr size_t WS_CTL = 0, CTL_ZERO_BYTES = 64 * 1024;
constexpr size_t WS_MODP = 1 * MiB;
constexpr size_t WS_MOD = WS_MODP + 1536 * 1024;
constexpr size_t WS_EIDX = 3 * MiB, WS_GATE = 4 * MiB;
constexpr size_t WS_ROWTOK = 5 * MiB, WS_ROWSLOT = WS_ROWTOK + 1280 * 1024, WS_ROWGATE = WS_ROWSLOT + 1280 * 1024;
constexpr size_t WS_WIN = 9 * MiB, WS_WGLU = 15 * MiB, WS_WFP = 17 * MiB, WS_WOUT = 19 * MiB, WS_WRT = 21 * MiB, WS_WSHGU = WS_WRT + 512 * 1024, WS_WSHDN = WS_WSHGU + 1 * MiB;
constexpr size_t WS_S5MB = 23 * MiB, WS_S5TC = 27 * MiB;
constexpr size_t WS_EDN = 36 * MiB, WS_EGU = 164 * MiB, WS_ACT = 420 * MiB;
constexpr size_t WS_U = 420 * MiB, WS_UX = 484 * MiB, WS_UFT = 548 * MiB, WS_GATES = 580 * MiB, WS_S = 708 * MiB, WS_DFT = 772 * MiB;
constexpr size_t WS_ZC = 836 * MiB, WS_Z = 900 * MiB, WS_P = 420 * MiB, WS_MERGED = 932 * MiB, WS_R1 = 580 * MiB  , WS_X1 = 836 * MiB;
constexpr size_t WS_U8 = 836 * MiB;
constexpr size_t WS_YT = 932 * MiB;
constexpr size_t WS_H8 = 544 * MiB;
constexpr size_t WS_SHARED = 420 * MiB;
constexpr size_t WS_LRANK = 540 * MiB, WS_CNTWG = 541 * MiB;
constexpr size_t WS_H = 420 * MiB, WS_LOGITS = 484 * MiB, WS_HIDSH = 516 * MiB, WS_HID = 676 * MiB, WS_YSLOT = 164 * MiB, WS_END = 1024 * MiB;
static_assert(WS_HID + (size_t)(MAXROWS + TOK) * 256 <= WS_X1 && WS_YSLOT + (size_t)TOK * TOPK * 2048 <= WS_HID && WS_X1 + (size_t)TOK * DM * 4 <= WS_END, "ws map");
constexpr int CW_BAR = 4096, CW_CNT = 8192, CW_CUR = 8448, CW_PAIR = 12288  ;

constexpr int RING_BYTES = 131072, LDSCTL_OFF = RING_BYTES, LDS_PS_OFF = LDSCTL_OFF + 256  , LDS_UEXP_OFF = LDSCTL_OFF + 1536  , LDS_TAB_OFF = LDSCTL_OFF + 2048  , LDS_BYTES = 163840;

typedef __bf16 bf16x2_t __attribute__((ext_vector_type(2)));
typedef float f32x2_t __attribute__((ext_vector_type(2)));
__device__ __forceinline__ unsigned cvt_pk_bf16(float lo, float hi) { const f32x2_t f = {lo, hi}; const bf16x2_t v = __builtin_convertvector(f, bf16x2_t); return __builtin_bit_cast(unsigned, v); }
constexpr float YS_SCALE = 64.f, W_SCALE = 64.f, H_SCALE = 8.f, HID_SCALE = 8.f, U_SCALE = 8.f;
constexpr float INPROJ_DESCALE = 1.f / (W_SCALE * U_SCALE);
constexpr float Z_SCALE = 8.f, ZC_SCALE = 0.0625f, WFP_SCALE = 2048.f;
constexpr float MG_SCALE = 8.f;
__device__ __forceinline__ float sat8(float v) { return __builtin_amdgcn_fmed3f(v, -448.f, 448.f); }
__device__ __forceinline__ unsigned pk4_fp8(const f32x4 v, float sc) { const f32x4 t = v * sc; int w = 0; w = __builtin_amdgcn_cvt_pk_fp8_f32(t.x, t.y, w, false); w = __builtin_amdgcn_cvt_pk_fp8_f32(t.z, t.w, w, true); return (unsigned)w; }
__device__ __forceinline__ f32x4 unpk4_fp8(unsigned w) { typedef float f2_t __attribute__((ext_vector_type(2))); const f2_t lo = __builtin_amdgcn_cvt_pk_f32_fp8((int)w, false), hi = __builtin_amdgcn_cvt_pk_f32_fp8((int)w, true); return (f32x4){lo.x, lo.y, hi.x, hi.y}; }
constexpr float P_SCALE = 8.f;
constexpr float GATE_SCALE = 256.f;
__device__ __forceinline__ float bf_lo(unsigned u) { return __builtin_bit_cast(float, u << 16); }
__device__ __forceinline__ float bf_hi(unsigned u) { return __builtin_bit_cast(float, u & 0xffff0000u); }
__device__ __forceinline__ void fast_sincos(float rad, float& sn, float& cs) { const float rev = __builtin_amdgcn_fractf(rad * 0.15915494309189535f); sn = __builtin_amdgcn_sinf(rev); cs = __builtin_amdgcn_cosf(rev); }
__device__ __forceinline__ float sigm(float x) { return __builtin_amdgcn_rcpf(1.f + __expf(-x)); }
__device__ __forceinline__ float gelu_tanh(float x) { return x * sigm(1.5957691216057308f * (x + 0.044715f * x * x * x)); }
template <int CTRL> __device__ __forceinline__ float dpp_f(float v) { return __builtin_bit_cast(float, __builtin_amdgcn_update_dpp(0, __builtin_bit_cast(int, v), CTRL, 0xf, 0xf, true)); }
__device__ __forceinline__ float wave_sum(float v) {
    v += dpp_f<0xB1>(v); v += dpp_f<0x4E>(v); v += dpp_f<0x141>(v); v += dpp_f<0x140>(v);
#if defined(__HIP_DEVICE_COMPILE__)
    { auto r = __builtin_amdgcn_permlane16_swap(__float_as_uint(v), __float_as_uint(v), false, false); v = __uint_as_float(r[0]) + __uint_as_float(r[1]); }
    { auto r = __builtin_amdgcn_permlane32_swap(__float_as_uint(v), __float_as_uint(v), false, false); v = __uint_as_float(r[0]) + __uint_as_float(r[1]); }
#endif
    return v;
}
#define CFENCE() asm volatile("" ::: "memory")
#define LDS_WAIT() asm volatile("s_waitcnt lgkmcnt(0)" ::: "memory")
#define VM_WAIT() asm volatile("s_waitcnt vmcnt(0)" ::: "memory")

#define XB_TMO      128
#define XB_XCNT(j)  (256  + 64 * (j))
#define XB_XSUB(j)  (1280 + 64 * (j))
#define XB_XGEN(j)  (2304 + 64 * (j))
#define XB_TOP      3328
#define XB_TOPGEN   3392
#define XCD_BAR_WORDS 3456
#define XB_SPIN_CAP (1u << 18)
__device__ __forceinline__ unsigned xb_ld(unsigned* p)              { return __hip_atomic_load(p, __ATOMIC_RELAXED, __HIP_MEMORY_SCOPE_AGENT); }
__device__ __forceinline__ unsigned xb_add(unsigned* p, unsigned v) { return __hip_atomic_fetch_add(p, v, __ATOMIC_RELAXED, __HIP_MEMORY_SCOPE_AGENT); }
__device__ __forceinline__ unsigned xb_xcc_id() { return (unsigned)__builtin_amdgcn_s_getreg((3 << 11) | 20) & 0xFu; }
#define XB_SPIN(cond, bar) do { unsigned _sp = 0; while (cond) { __builtin_amdgcn_s_sleep(1); \
    if ((++_sp & 255u) == 0u) { if (xb_ld(&(bar)[XB_TMO])) break; if (_sp > XB_SPIN_CAP) { atomicAdd(&(bar)[XB_TMO], 1u); break; } } } } while (0)
struct XcdBarrier { unsigned* bar; unsigned x; volatile LAS unsigned* st; };
__device__ __forceinline__ XcdBarrier xcd_barrier_post(unsigned* bar, volatile LAS unsigned* st) {
    XcdBarrier b; b.bar = bar; b.x = xb_xcc_id(); b.st = st;
    if (threadIdx.x == 0) (void)xb_add(&bar[XB_XCNT(b.x)], 1u);
    return b;
}
__device__ __forceinline__ void xcd_barrier_complete(unsigned* bar, unsigned x, unsigned& nloc, unsigned& nx) {
    const unsigned G = gridDim.x * gridDim.y * gridDim.z;
    unsigned sum, cnt, mine, sp = 0u;
    for (;;) {
        sum = 0u; cnt = 0u; mine = 0u;
#pragma unroll
        for (unsigned j = 0; j < 16; ++j) { const unsigned c = xb_ld(&bar[XB_XCNT(j)]); sum += c; cnt += (c > 0u) ? 1u : 0u; mine = (j == x) ? c : mine; }
        if (sum == G) break;
        __builtin_amdgcn_s_sleep(1);
        if ((++sp & 255u) == 0u) { if (xb_ld(&bar[XB_TMO])) break; if (sp > XB_SPIN_CAP) { atomicAdd(&bar[XB_TMO], 1u); break; } }
    }
    nloc = mine > 0u ? mine : 1u; nx = cnt > 0u ? cnt : 1u;
}
__device__ __forceinline__ void xcd_barrier(const XcdBarrier& b) {
    asm volatile("s_waitcnt vmcnt(0)" ::: "memory");
    __syncthreads();
    if (threadIdx.x == 0) {
        unsigned* bar = b.bar;
        __builtin_amdgcn_s_waitcnt(0);
        unsigned nloc = b.st[0], nx = b.st[1];
        if (nloc == 0u) { xcd_barrier_complete(bar, b.x, nloc, nx); b.st[0] = nloc; b.st[1] = nx; }
        const unsigned old = xb_add(&bar[XB_XSUB(b.x)], 1u);
        const unsigned gen = old / nloc;
        if (old + 1u == (gen + 1u) * nloc) {
            __builtin_amdgcn_fence(__ATOMIC_RELEASE, "agent");
            asm volatile("s_waitcnt vmcnt(0)" ::: "memory");
            const unsigned og = xb_add(&bar[XB_TOP], 1u);
            const unsigned tg = og / nx;
            if (og + 1u == (tg + 1u) * nx) xb_add(&bar[XB_TOPGEN], 1u);
            else XB_SPIN(xb_ld(&bar[XB_TOPGEN]) == tg, bar);
            __builtin_amdgcn_fence(__ATOMIC_ACQUIRE, "agent");
            xb_add(&bar[XB_XGEN(b.x)], 1u);
            asm volatile("s_waitcnt vmcnt(0)" ::: "memory");
        } else {
            XB_SPIN(xb_ld(&bar[XB_XGEN(b.x)]) == gen, bar);
            __builtin_amdgcn_fence(__ATOMIC_ACQUIRE, "agent");
            asm volatile("s_waitcnt vmcnt(0)" ::: "memory");
        }
    }
    __syncthreads();
}

namespace pg8 {
constexpr int BM = 256, BK = 64, HALF = 128, HTB = HALF * BK * 2, STAGE_BYTES = 8 * HTB;
__host__ __device__ __forceinline__ int lds_byte(int r, int c) { const int st = (r >> 4) * 2 + (c >> 5), rr = r & 15, cc = c & 31, ob = rr * 64 + cc * 2; return st * 1024 + (ob ^ (((ob >> 9) & 1) << 5)); }
__host__ __device__ __forceinline__ void stage_rc(int b, int& R, int& C) { const int st = b / 1024, sb = b % 1024, swz = sb ^ (((sb >> 9) & 1) << 5); R = (st >> 1) * 16 + swz / 64; C = (st & 1) * 32 + (swz % 64) / 2; }
__host__ __device__ __forceinline__ int perm32(int rho) { const int n = rho >> 4, i = rho & 15; return 8 * (i >> 2) + 4 * n + (i & 3); }
struct Unit { int pm, pn, z, li; };
typedef int i32x4_t __attribute__((ext_vector_type(4)));
typedef int i32x8_t __attribute__((ext_vector_type(8)));
struct FragT { bf16x8 lo, hi; };
template <bool F8> struct FragSel { typedef FragT type; };
template <> struct FragSel<true> { typedef i32x8_t type; };
__device__ __forceinline__ void frag_load(FragT& d, const LAS unsigned char* p0, const LAS unsigned char* p1) { d.lo = *(const LAS bf16x8*)p0; d.hi = *(const LAS bf16x8*)p1; }
__device__ __forceinline__ void frag_load(i32x8_t& d, const LAS unsigned char* p0, const LAS unsigned char* p1) { const i32x4_t lo = *(const LAS i32x4_t*)p0, hi = *(const LAS i32x4_t*)p1; d = __builtin_shufflevector(lo, hi, 0, 1, 2, 3, 4, 5, 6, 7); }
typedef float f32x4_acc __attribute__((ext_vector_type(4)));
__device__ __forceinline__ void frag_mma(f32x4_acc& c, const FragT& b, const FragT& a) { c = __builtin_amdgcn_mfma_f32_16x16x32_bf16(b.lo, a.lo, c, 0, 0, 0); c = __builtin_amdgcn_mfma_f32_16x16x32_bf16(b.hi, a.hi, c, 0, 0, 0); }
__device__ __forceinline__ void frag_mma(f32x4_acc& c, const i32x8_t& b, const i32x8_t& a) {
#if defined(__HIP_DEVICE_COMPILE__)
    const int sc = 0x7f7f7f7f;
    asm volatile("v_mfma_scale_f32_16x16x128_f8f6f4 %0, %1, %2, %0, %3, %3 op_sel_hi:[0,0,0]" : "+v"(c) : "v"(b), "v"(a), "v"(sc));
#else
    (void)c; (void)b; (void)a;
#endif
}

template <class Epi, class Sched, bool ALIGN_EPI, bool SP2, bool F8 = false, int NST = -1>
__device__ __forceinline__ void gemm_phase(LAS unsigned char* lds, const Sched& S, const Epi& E) {
    const int tid = threadIdx.x, wid = __builtin_amdgcn_readfirstlane(tid >> 6), lane = tid & 63, wr = wid >> 2, wc = wid & 3, fr = lane & 15, fq = lane >> 4;
    const int nt = S.nt;
    int sR[2], sC[2];
    unsigned voffA[2] = {0u, 0u}, vB[2][2];
#pragma unroll
    for (int i = 0; i < 2; ++i) { stage_rc(tid * 16 + i * 8192, sR[i], sC[i]); const int Rb = (sR[i] & ~31) + perm32(sR[i] & 31);
#pragma unroll
        for (int h = 0; h < 2; ++h) { if constexpr (Sched::BMAP) vB[h][i] = S.b_row_off(S.b_map(128 * h + sR[i])) + (unsigned)sC[i] * 2u;
                                      else vB[h][i] = S.b_row_off(Rb) + (unsigned)(h * S.hstepB) + (unsigned)sC[i] * 2u; }
        if constexpr (!Sched::GATHER) voffA[i] = S.a_row_off(sR[i]) + (unsigned)sC[i] * 2u; }
    unsigned vAc[2][2] = {{0u, 0u}, {0u, 0u}}, vAn[2][2] = {{0u, 0u}, {0u, 0u}};
    const size_t kstepA = S.kstepA, kstepB = S.kstepB, hstepA = S.hstepA;
    const unsigned ldsw = (unsigned)wid * 1024u;
    const int f8a = 16 * fq + 8 * (fq & 1), f8b = 16 * fq + 8 * ((fq & 1) ^ 1);
    const int aoff0 = F8 ? lds_byte(wr * 64 + fr, f8a) : lds_byte(wr * 64 + fr, fq * 8), aoff1 = F8 ? lds_byte(wr * 64 + fr, f8b) : aoff0 + 1024;
    const int boff0 = F8 ? lds_byte(wc * 32 + fr, f8a) : lds_byte(wc * 32 + fr, fq * 8), boff1 = F8 ? lds_byte(wc * 32 + fr, f8b) : boff0 + 1024;
#define PG8_SA(b, h) (((b) * 2 + (h)) * HTB)
#define PG8_SB(b, h) ((4 + (b) * 2 + (h)) * HTB)
#define PG8_STAGE(bufoff, gbase, voff) do { _Pragma("unroll") for (int _i = 0; _i < 2; ++_i) \
        __builtin_amdgcn_global_load_lds((const unsigned*)((const char*)(gbase) + (voff)[_i]), (LAS unsigned*)(lds + (bufoff) + ldsw + _i * 8192), 16, 0, 0); } while (0)
#define PG8_STA_CUR(bufoff, kb, h) do { if constexpr (Sched::GATHER) { PG8_STAGE(bufoff, kb, vAc[h]); } else { PG8_STAGE(bufoff, (kb) + (h) * hstepA, voffA); } } while (0)
#define PG8_STA_NX(bufoff, kb, h) do { if constexpr (Sched::GATHER) { const unsigned _v[2] = {last ? vAn[h][0] : vAc[h][0], last ? vAn[h][1] : vAc[h][1]}; PG8_STAGE(bufoff, kb, _v); } else { PG8_STAGE(bufoff, (kb) + (h) * hstepA, voffA); } } while (0)
#define PG8_STB(bufoff, kb, h) PG8_STAGE(bufoff, kb, vB[h])
#define PG8_LDA(dst, b, h) do { _Pragma("unroll") for (int m = 0; m < 4; ++m) frag_load(dst[m], lds + PG8_SA(b, h) + aoff0 + m * 2048, lds + PG8_SA(b, h) + aoff1 + m * 2048); } while (0)
#define PG8_LDB(dst, b, h) do { _Pragma("unroll") for (int n = 0; n < 2; ++n) frag_load(dst[n], lds + PG8_SB(b, h) + boff0 + n * 2048, lds + PG8_SB(b, h) + boff1 + n * 2048); } while (0)
#define PG8_MMA(ai, bj, At, Bt) do { __builtin_amdgcn_s_setprio(1); _Pragma("unroll") for (int m = 0; m < 4; ++m) _Pragma("unroll") for (int n = 0; n < 2; ++n) frag_mma(acc[ai][bj][m][n], Bt[n], At[m]); __builtin_amdgcn_s_setprio(0); } while (0)
#define PG8_WAIT_V(n) asm volatile("s_waitcnt vmcnt(" #n ")" ::: "memory")
#define PG8_WAIT_L(n) asm volatile("s_waitcnt lgkmcnt(" #n ")" ::: "memory")
#define PG8_WAIT_VC(n) asm volatile("s_waitcnt vmcnt(%0)" :: "n"(n) : "memory")
#define PG8_BAR __builtin_amdgcn_s_barrier()
#define PG8_SCHED __builtin_amdgcn_sched_barrier(0)
#define PG8_KBODY \
            const bool last = (t == nt - 2); \
            const char* a1 = cA + (size_t)(t + 1) * kstepA; \
            const char* a2 = last ? nA : cA + (size_t)(t + 2) * kstepA; const char* b2 = last ? nB : cB + (size_t)(t + 2) * kstepB; \
            const char* a3 = a2 + kstepA; const char* b3 = b2 + kstepB; \
            if constexpr (SP2) { \
            PG8_LDB(B0, 0, 0); PG8_LDB(B1, 0, 1); PG8_SCHED; PG8_LDA(At, 0, 0); PG8_STA_CUR(PG8_SA(1, 1), a1, 1); \
            PG8_WAIT_V(8); PG8_WAIT_L(0); PG8_BAR; PG8_MMA(0, 0, At, B0); PG8_MMA(0, 1, At, B1); PG8_BAR; PG8_SCHED; \
            PG8_LDA(At, 0, 1); PG8_STB(PG8_SB(0, 0), b2, 0); PG8_STB(PG8_SB(0, 1), b2, 1); PG8_STA_NX(PG8_SA(0, 0), a2, 0); \
            PG8_WAIT_V(8); PG8_WAIT_L(0); PG8_BAR; PG8_MMA(1, 0, At, B0); PG8_MMA(1, 1, At, B1); PG8_BAR; PG8_SCHED; \
            PG8_LDB(B0, 1, 0); PG8_LDB(B1, 1, 1); PG8_SCHED; PG8_LDA(At, 1, 0); PG8_STA_NX(PG8_SA(0, 1), a2, 1); \
            PG8_WAIT_V(8); PG8_WAIT_L(0); PG8_BAR; PG8_MMA(0, 0, At, B0); PG8_MMA(0, 1, At, B1); PG8_BAR; PG8_SCHED; \
            PG8_LDA(At, 1, 1); PG8_STB(PG8_SB(1, 0), b3, 0); PG8_STB(PG8_SB(1, 1), b3, 1); PG8_STA_NX(PG8_SA(1, 0), a3, 0); \
            PG8_WAIT_V(8); PG8_WAIT_L(0); PG8_BAR; PG8_MMA(1, 0, At, B0); PG8_MMA(1, 1, At, B1); PG8_BAR; PG8_SCHED; \
            } else { \
            PG8_LDB(B0, 0, 0); PG8_SCHED; PG8_LDA(At, 0, 0); PG8_STA_CUR(PG8_SA(1, 1), a1, 1); \
            PG8_WAIT_L(8); PG8_BAR; PG8_WAIT_L(0); PG8_MMA(0, 0, At, B0); PG8_BAR; PG8_SCHED; \
            PG8_LDB(B1, 0, 1); PG8_STB(PG8_SB(0, 0), b2, 0); \
            PG8_BAR; PG8_WAIT_L(0); PG8_MMA(0, 1, At, B1); PG8_BAR; \
            PG8_LDA(At, 0, 1); PG8_STA_NX(PG8_SA(0, 0), a2, 0); \
            PG8_BAR; PG8_WAIT_L(0); PG8_MMA(1, 0, At, B0); PG8_BAR; PG8_SCHED; \
            PG8_STB(PG8_SB(0, 1), b2, 1); \
            PG8_WAIT_V(6); PG8_BAR; PG8_MMA(1, 1, At, B1); PG8_BAR; \
            PG8_LDB(B0, 1, 0); PG8_SCHED; PG8_LDA(At, 1, 0); PG8_STA_NX(PG8_SA(0, 1), a2, 1); \
            PG8_WAIT_L(8); PG8_BAR; PG8_WAIT_L(0); PG8_MMA(0, 0, At, B0); PG8_BAR; PG8_SCHED; \
            PG8_LDB(B1, 1, 1); PG8_STB(PG8_SB(1, 0), b3, 0); \
            PG8_BAR; PG8_WAIT_L(0); PG8_MMA(0, 1, At, B1); PG8_BAR; \
            PG8_LDA(At, 1, 1); PG8_STA_NX(PG8_SA(1, 0), a3, 0); \
            PG8_BAR; PG8_WAIT_L(0); PG8_MMA(1, 0, At, B0); PG8_BAR; PG8_SCHED; \
            PG8_STB(PG8_SB(1, 1), b3, 1); \
            PG8_WAIT_V(6); PG8_BAR; PG8_MMA(1, 1, At, B1); PG8_BAR; \
            }
#define PG8_KBODY_NT2 \
            const bool last = true; (void)last; \
            PG8_LDB(B0, 0, 0); PG8_LDB(B1, 0, 1); PG8_SCHED; PG8_LDA(At, 0, 0); \
            PG8_WAIT_VC(8 + NST); PG8_WAIT_L(0); PG8_BAR; PG8_MMA(0, 0, At, B0); PG8_MMA(0, 1, At, B1); PG8_BAR; PG8_SCHED; \
            PG8_LDA(At, 0, 1); PG8_STB(PG8_SB(0, 0), nB, 0); PG8_STB(PG8_SB(0, 1), nB, 1); PG8_STA_NX(PG8_SA(0, 0), nA, 0); \
            PG8_WAIT_VC(8 + NST); PG8_WAIT_L(0); PG8_BAR; PG8_MMA(1, 0, At, B0); PG8_MMA(1, 1, At, B1); PG8_BAR; PG8_SCHED; \
            PG8_LDB(B0, 1, 0); PG8_LDB(B1, 1, 1); PG8_SCHED; PG8_LDA(At, 1, 0); PG8_STA_NX(PG8_SA(0, 1), nA, 1); \
            PG8_WAIT_VC(8 + NST); PG8_WAIT_L(0); PG8_BAR; PG8_MMA(0, 0, At, B0); PG8_MMA(0, 1, At, B1); PG8_BAR; PG8_SCHED; \
            PG8_LDA(At, 1, 1); PG8_STB(PG8_SB(1, 0), nB + kstepB, 0); PG8_STB(PG8_SB(1, 1), nB + kstepB, 1); PG8_STA_NX(PG8_SA(1, 0), nA + kstepA, 0); \
            PG8_WAIT_V(8); PG8_WAIT_L(0); PG8_BAR; PG8_MMA(1, 0, At, B0); PG8_MMA(1, 1, At, B1); PG8_BAR; PG8_SCHED; \
            PG8_STA_NX(PG8_SA(1, 1), nA + kstepA, 1);
    Unit cur, nxt; int ui = 0;
    if (!S.next(0, cur)) return;
    f32x4 acc[2][2][4][2];
#pragma unroll
    for (int a = 0; a < 2; ++a)
#pragma unroll
        for (int b = 0; b < 2; ++b)
#pragma unroll
            for (int m = 0; m < 4; ++m)
#pragma unroll
                for (int n = 0; n < 2; ++n) acc[a][b][m][n] = (f32x4){0.f, 0.f, 0.f, 0.f};
    typename FragSel<F8>::type At[4], B0[2], B1[2];
    const char* cA = S.a_base(cur); const char* cB = S.b_base(cur);
    if constexpr (Sched::GATHER) {
#pragma unroll
        for (int h = 0; h < 2; ++h)
#pragma unroll
            for (int i = 0; i < 2; ++i) vAc[h][i] = S.a_gather_off(cur, h * HALF + sR[i]) + (unsigned)sC[i] * 2u;
    }
    {   const bool last = false; (void)last;
    if constexpr (NST >= 0) {
        PG8_STB(PG8_SB(0, 0), cB, 0); PG8_STB(PG8_SB(0, 1), cB, 1); PG8_STA_CUR(PG8_SA(0, 0), cA, 0); PG8_STA_CUR(PG8_SA(0, 1), cA, 1);
        PG8_STB(PG8_SB(1, 0), cB + kstepB, 0); PG8_STB(PG8_SB(1, 1), cB + kstepB, 1); PG8_STA_CUR(PG8_SA(1, 0), cA + kstepA, 0); PG8_STA_CUR(PG8_SA(1, 1), cA + kstepA, 1);
        PG8_WAIT_V(0); PG8_BAR;
        if (wr == 1) PG8_BAR;
    } else if constexpr (SP2) {
        PG8_STB(PG8_SB(0, 0), cB, 0); PG8_STB(PG8_SB(0, 1), cB, 1); PG8_STA_CUR(PG8_SA(0, 0), cA, 0); PG8_STA_CUR(PG8_SA(0, 1), cA, 1);
        if (wr == 1) PG8_BAR;
        PG8_WAIT_V(2); PG8_BAR;
        PG8_STB(PG8_SB(1, 0), cB + kstepB, 0); PG8_STA_CUR(PG8_SA(1, 0), cA + kstepA, 0); PG8_STB(PG8_SB(1, 1), cB + kstepB, 1);
        PG8_WAIT_V(6); PG8_BAR;
    } else {
        PG8_STB(PG8_SB(0, 0), cB, 0); PG8_STA_CUR(PG8_SA(0, 0), cA, 0); PG8_STB(PG8_SB(0, 1), cB, 1); PG8_STA_CUR(PG8_SA(0, 1), cA, 1);
        if (wr == 1) PG8_BAR;
        PG8_WAIT_V(4); PG8_BAR;
        PG8_STB(PG8_SB(1, 0), cB + kstepB, 0); PG8_STA_CUR(PG8_SA(1, 0), cA + kstepA, 0); PG8_STB(PG8_SB(1, 1), cB + kstepB, 1);
        PG8_WAIT_V(6); PG8_BAR;
    } }
    for (;;) {
        const bool has_next = S.next(ui + 1, nxt);
        const char* nA = has_next ? S.a_base(nxt) : cA; const char* nB = has_next ? S.b_base(nxt) : cB;
        if constexpr (Sched::GATHER) {
#pragma unroll
            for (int h = 0; h < 2; ++h)
#pragma unroll
                for (int i = 0; i < 2; ++i) vAn[h][i] = S.a_gather_off(has_next ? nxt : cur, h * HALF + sR[i]) + (unsigned)sC[i] * 2u;
        }
        if constexpr (NST >= 0) { PG8_KBODY_NT2 } else { for (int t = 0; t < nt; t += 2) { PG8_KBODY } }
        if constexpr (ALIGN_EPI) { if (wr == 0) PG8_BAR; }
        if constexpr (F8) asm volatile("s_nop 15\n\ts_nop 15" ::: "memory");
        { int tz = threadIdx.x; asm volatile("" : "+v"(tz));
          const int ewid = __builtin_amdgcn_readfirstlane(tz >> 6), el = tz & 63; E(acc, cur, ewid >> 2, ewid & 3, el & 15, el >> 4); }
        if (!has_next) break;
#pragma unroll
        for (int a = 0; a < 2; ++a)
#pragma unroll
            for (int b = 0; b < 2; ++b)
#pragma unroll
                for (int m = 0; m < 4; ++m)
#pragma unroll
                    for (int n = 0; n < 2; ++n) acc[a][b][m][n] = (f32x4){0.f, 0.f, 0.f, 0.f};
        cur = nxt; cA = nA; cB = nB; ++ui;
        if constexpr (Sched::GATHER) {
#pragma unroll
            for (int h = 0; h < 2; ++h)
#pragma unroll
                for (int i = 0; i < 2; ++i) vAc[h][i] = vAn[h][i];
        }
        if constexpr (ALIGN_EPI) { if (wr == 1) PG8_BAR; }
    }
    PG8_WAIT_V(0);
    if constexpr (!ALIGN_EPI) { if (wr == 0) PG8_BAR; }
    PG8_BAR;
#undef PG8_SA
#undef PG8_SB
#undef PG8_STAGE
#undef PG8_STA_CUR
#undef PG8_STA_NX
#undef PG8_STB
#undef PG8_LDA
#undef PG8_LDB
#undef PG8_MMA
#undef PG8_WAIT_V
#undef PG8_WAIT_L
#undef PG8_BAR
#undef PG8_SCHED
#undef PG8_KBODY
#undef PG8_KBODY_NT2
#undef PG8_WAIT_VC
}
}
using pg8::Unit;

struct SchedDense {
    static constexpr bool GATHER = false, BMAP = false;
    __device__ __forceinline__ int b_map(int r) const { return r; }
    const char* A; const char* B; unsigned lda, ldb; size_t zA, zB; int nM, nN, nZ, nt, G, c;
    size_t kstepA, kstepB, hstepA, hstepB;
    __device__ __forceinline__ void init(const void* A_, unsigned lda_, size_t zA_, const void* B_, unsigned ldb_, size_t zB_, int nM_, int nN_, int nZ_, int K, int G_, int c_) {
        A = (const char*)A_; B = (const char*)B_; lda = lda_; ldb = ldb_; zA = zA_; zB = zB_; nM = nM_; nN = nN_; nZ = nZ_; nt = K / 64; G = G_; c = c_;
        kstepA = 128; kstepB = 128; hstepA = (size_t)128 * lda; hstepB = (size_t)128 * ldb; }
    __device__ __forceinline__ bool next(int i, Unit& u) const { const int L = i * G + c, per = nM * nN; if (L >= per * nZ) return false; u.z = L / per; const int w = L % per; u.pm = w / nN; u.pn = w % nN; u.li = i; return true; }
    __device__ __forceinline__ const char* a_base(const Unit& u) const { return A + (size_t)u.z * zA + (size_t)u.pm * 256 * lda; }
    __device__ __forceinline__ const char* b_base(const Unit& u) const { return B + (size_t)u.z * zB + (size_t)u.pn * 256 * ldb; }
    __device__ __forceinline__ unsigned a_row_off(int r) const { return (unsigned)r * lda; }
    __device__ __forceinline__ unsigned b_row_off(int r) const { return (unsigned)r * ldb; }
    __device__ __forceinline__ unsigned a_gather_off(const Unit&, int) const { return 0u; }
};
struct SchedPanel : SchedDense {
    int npc;
    __device__ __forceinline__ bool next(int i, Unit& u) const { if (i >= npc) return false; u.z = 0; u.li = i; u.pm = c >> 1; u.pn = (c & 1) * npc + i; return true; }
};
template <int NT, bool GATHER_, bool BMAP_ = false> struct SchedExp {
    static constexpr bool GATHER = GATHER_, BMAP = BMAP_;
    __device__ __forceinline__ int b_map(int r) const { return 64 * ((r >> 5) & 3) + 16 * ((r >> 2) & 3) + 8 * (r >> 7) + 4 * ((r >> 4) & 1) + (r & 3); }
    const char* A; const char* B; const LAS int* row_tok  ; const LAS int* ps; const LAS int* uexp; unsigned lda, ldb; size_t eB, tB; int ntiles, nsh  , nt, G, c, dbg = 0;
    size_t kstepA, kstepB, hstepA, hstepB;
    __device__ __forceinline__ bool next(int i, Unit& u) const {
        const int L = i * G + c, tl = L / NT; if (tl >= ntiles + nsh) return false;
        u.pm = tl < ntiles ? tl : SH_TILE0 + (tl - ntiles); u.pn = L % NT; u.li = i; u.z = __builtin_amdgcn_readfirstlane(uexp[i]); return true; }
    __device__ __forceinline__ void fill_unit_experts(LAS int* tab) const {
        const int per = ((ntiles + nsh) * NT + G - 1) / G;
        if ((int)threadIdx.x < per) { const int mt = ((int)threadIdx.x * G + c) / NT; const int r0 = mt * 256; int lo = 0, hi = NEXP;
#pragma unroll
            for (int s = 0; s < 8; ++s) { const int mid = (lo + hi) >> 1; if (ps[mid] <= r0) lo = mid; else hi = mid; }
            tab[threadIdx.x] = mt < ntiles ? lo : NEXP; }
        __syncthreads(); }
    __device__ __forceinline__ const char* a_base(const Unit& u) const { return GATHER_ ? A : A + (size_t)((dbg & 2) ? c : u.pm) * 256 * lda; }
    __device__ __forceinline__ const char* b_base(const Unit& u) const { return B + (size_t)((dbg & 2) ? 0 : u.z) * eB + (size_t)u.pn * tB; }
    __device__ __forceinline__ unsigned a_row_off(int r) const { return (unsigned)r * lda; }
    __device__ __forceinline__ unsigned b_row_off(int r) const { return (unsigned)r * ldb; }
    __device__ __forceinline__ unsigned a_gather_off(const Unit& u, int r) const { return (unsigned)row_tok[u.li * 256 + r] * lda; }
};

typedef const f32x4 (&AccRef)[2][2][4][2];
#define EPI_ROWS for (int ai = 0; ai < 2; ++ai) _Pragma("unroll") for (int m = 0; m < 4; ++m)
#define EPI_ROWS_PIN for (int ai = 0; ai < 2; ++ai) _Pragma("unroll") for (int m = 0; m < 4; ++m, pin_mem(m))
__device__ __forceinline__ void pin_mem(int m) { (void)m; }
#define EPI_ROW_L (128 * ai + 64 * wr + 16 * m + fr)
#define EPI_COL_L(bj) (128 * (bj) + 32 * wc + 8 * fq)
__device__ __forceinline__ u32x4 pack8(const f32x4 a, const f32x4 b) { u32x4 o; o.x = cvt_pk_bf16(a.x, a.y); o.y = cvt_pk_bf16(a.z, a.w); o.z = cvt_pk_bf16(b.x, b.y); o.w = cvt_pk_bf16(b.z, b.w); return o; }
__device__ __forceinline__ void unpack8(const u32x4 v, f32x4& a, f32x4& b) { a = (f32x4){bf_lo(v.x), bf_hi(v.x), bf_lo(v.y), bf_hi(v.y)}; b = (f32x4){bf_lo(v.z), bf_hi(v.z), bf_lo(v.w), bf_hi(v.w)}; }
__device__ __forceinline__ f32x4 sigm4(f32x4 v) { return (f32x4){sigm(v.x), sigm(v.y), sigm(v.z), sigm(v.w)}; }

struct EpiS5U { bf16_t* UX; const LAS float* bias;
    __device__ __forceinline__ void operator()(AccRef acc, const Unit& u, int wr, int wc, int fr, int fq) const {
#pragma unroll
        for (int bj = 0; bj < 2; ++bj) { const int c = 256 * u.pn + EPI_COL_L(bj); const f32x4 b0 = *(const LAS f32x4*)(bias + c), b1 = *(const LAS f32x4*)(bias + c + 4); const int g = c >> 4, h0 = c & 15;
#pragma unroll
            EPI_ROWS { const int t = 256 * u.pm + EPI_ROW_L;
                *(u32x4*)(UX + ((size_t)(g * 2048 + (t >> 4)) * 512 + (t & 15) * 16 + h0)) = pack8(acc[ai][bj][m][0] * INPROJ_DESCALE + b0, acc[ai][bj][m][1] * INPROJ_DESCALE + b1); } }
    } };
struct EpiFT { bf16_t* UFT; const LAS float* bias  ;
    __device__ __forceinline__ void operator()(AccRef acc, const Unit& u, int wr, int wc, int fr, int fq) const {
#pragma unroll
        EPI_ROWS { const int ch = 256 * u.pm + EPI_ROW_L; const float bv = bias[ch];
#pragma unroll
            for (int bj = 0; bj < 2; ++bj) { const int t = 256 * u.pn + EPI_COL_L(bj);
                *(u32x4*)(UFT + (size_t)ch * TOK + t) = pack8(acc[ai][bj][m][0] * INPROJ_DESCALE + bv, acc[ai][bj][m][1] * INPROJ_DESCALE + bv); } }
    } };
struct EpiGate { unsigned char* GT; const LAS float* bias  ;
    __device__ __forceinline__ void operator()(AccRef acc, const Unit& u, int wr, int wc, int fr, int fq) const {
#pragma unroll
        for (int bj = 0; bj < 2; ++bj) { const int c = 256 * u.pn + EPI_COL_L(bj); const f32x4 b0 = *(const LAS f32x4*)(bias + c), b1 = *(const LAS f32x4*)(bias + c + 4);
#pragma unroll
            EPI_ROWS { const int t = 256 * u.pm + EPI_ROW_L;
                *(u32x2*)(GT + (size_t)t * 2048 + c) = (u32x2){pk4_fp8(sigm4(acc[ai][bj][m][0] * INPROJ_DESCALE + b0), GATE_SCALE), pk4_fp8(sigm4(acc[ai][bj][m][1] * INPROJ_DESCALE + b1), GATE_SCALE)}; } }
    } };
struct EpiB16 { bf16_t* C; int ldc; size_t zC;
    __device__ __forceinline__ void operator()(AccRef acc, const Unit& u, int wr, int wc, int fr, int fq) const {
#pragma unroll
        for (int bj = 0; bj < 2; ++bj) { const int c = 256 * u.pn + EPI_COL_L(bj);
#pragma unroll
            EPI_ROWS { const int r = 256 * u.pm + EPI_ROW_L; *(u32x4*)(C + (size_t)u.z * zC + (size_t)r * ldc + c) = pack8(acc[ai][bj][m][0], acc[ai][bj][m][1]); } }
    } };
struct EpiF32 { float* C; int ldc; size_t zC;
    __device__ __forceinline__ void operator()(AccRef acc, const Unit& u, int wr, int wc, int fr, int fq) const {
#pragma unroll
        for (int bj = 0; bj < 2; ++bj) { const int c = 256 * u.pn + EPI_COL_L(bj);
#pragma unroll
            EPI_ROWS { const int r = 256 * u.pm + EPI_ROW_L; float* p = C + (size_t)u.z * zC + (size_t)r * ldc + c;
                *(f32x4*)p = acc[ai][bj][m][0]; *(f32x4*)(p + 4) = acc[ai][bj][m][1]; } }
    } };
struct EpiS5Y { unsigned char* Z;
    __device__ __forceinline__ void operator()(AccRef acc, const Unit& u, int wr, int wc, int fr, int fq) const {
#pragma unroll
        for (int bj = 0; bj < 2; ++bj) { const int c = EPI_COL_L(bj), i = c >> 4, h0 = c & 15;
#pragma unroll
            EPI_ROWS { const int rr = 256 * u.pm + EPI_ROW_L; const int t = rr * 16 + i; f32x4 a = acc[ai][bj][m][0], b = acc[ai][bj][m][1];
                a = (f32x4){gelu_tanh(a.x), gelu_tanh(a.y), gelu_tanh(a.z), gelu_tanh(a.w)}; b = (f32x4){gelu_tanh(b.x), gelu_tanh(b.y), gelu_tanh(b.z), gelu_tanh(b.w)};
                *(u32x2*)(Z + (size_t)t * 512 + u.z * 16 + h0) = (u32x2){pk4_fp8(a, Z_SCALE), pk4_fp8(b, Z_SCALE)}; } }
    } };
struct EpiGlu { unsigned char* P; const LAS float* bias;
    __device__ __forceinline__ void operator()(AccRef acc, const Unit& u, int wr, int wc, int fr, int fq) const {
        const int oc = 128 * u.pn + 32 * wc + 8 * fq;
        const f32x4 a0 = *(const LAS f32x4*)(bias + oc), a1 = *(const LAS f32x4*)(bias + oc + 4), b0 = *(const LAS f32x4*)(bias + 1024 + oc), b1 = *(const LAS f32x4*)(bias + 1024 + oc + 4);
#pragma unroll
        EPI_ROWS { const int t = 256 * u.pm + EPI_ROW_L;
            constexpr float ds = 1.f / (W_SCALE * Z_SCALE);
            const f32x4 v0 = (acc[ai][0][m][0] * ds + a0) * sigm4(acc[ai][1][m][0] * ds + b0), v1 = (acc[ai][0][m][1] * ds + a1) * sigm4(acc[ai][1][m][1] * ds + b1);
            *(u32x2*)(P + (size_t)t * 1024 + oc) = (u32x2){pk4_fp8(v0, P_SCALE), pk4_fp8(v1, P_SCALE)}; }
    } };
struct EpiMerge { unsigned char* MG; const unsigned char* P; const unsigned char* GT; const LAS float* bias;
    __device__ __forceinline__ void operator()(AccRef acc, const Unit& u, int wr, int wc, int fr, int fq) const {
#pragma unroll
        for (int bj = 0; bj < 2; ++bj) { const int c = 256 * u.pn + EPI_COL_L(bj); const f32x4 b0 = *(const LAS f32x4*)(bias + c) * P_SCALE, b1 = *(const LAS f32x4*)(bias + c + 4) * P_SCALE;
#pragma unroll
            EPI_ROWS_PIN { const int t = 256 * u.pm + EPI_ROW_L; const u32x2 gf = *(const u32x2*)(GT + (size_t)t * 2048 + 1024 + c), gs = *(const u32x2*)(GT + (size_t)t * 2048 + c); const u32x2 pp = *(const u32x2*)(P + (size_t)t * 1024 + c);
                const f32x4 g0 = unpk4_fp8(gf.x), g1 = unpk4_fp8(gf.y), s0 = unpk4_fp8(gs.x), s1 = unpk4_fp8(gs.y), p0 = unpk4_fp8(pp.x), p1 = unpk4_fp8(pp.y);
                *(u32x2*)(MG + (size_t)t * 1024 + c) = (u32x2){pk4_fp8(s0 * p0 + g0 * (acc[ai][bj][m][0] * (P_SCALE / (ZC_SCALE * WFP_SCALE)) + b0), MG_SCALE / (GATE_SCALE * P_SCALE)), pk4_fp8(s1 * p1 + g1 * (acc[ai][bj][m][1] * (P_SCALE / (ZC_SCALE * WFP_SCALE)) + b1), MG_SCALE / (GATE_SCALE * P_SCALE))}; } }
    } };
struct EpiOut { bf16_t* R1; const float* X; const float* mod; const float* bias;
    __device__ __forceinline__ void operator()(AccRef acc, const Unit& u, int wr, int wc, int fr, int fq) const {
        const int b = (256 * u.pm) / SEQ;
#pragma unroll
        for (int bj = 0; bj < 2; ++bj) { const int c = 256 * u.pn + EPI_COL_L(bj); const f32x4 b0 = *(const f32x4*)(bias + c), b1 = *(const f32x4*)(bias + c + 4);
            const f32x4 g0 = *(const f32x4*)(mod + b * 6144 + 2048 + c), g1 = *(const f32x4*)(mod + b * 6144 + 2048 + c + 4);
#pragma unroll
            EPI_ROWS_PIN { const size_t o = (size_t)(256 * u.pm + EPI_ROW_L) * 1024 + c; const f32x4 x0 = *(const f32x4*)(X + o), x1 = *(const f32x4*)(X + o + 4);
                *(u32x4*)(R1 + o) = pack8(x0 * ALPHA + g0 * (acc[ai][bj][m][0] * (1.f / (W_SCALE * MG_SCALE)) + b0), x1 * ALPHA + g1 * (acc[ai][bj][m][1] * (1.f / (W_SCALE * MG_SCALE)) + b1)); } }
    } };
struct EpiSwi { bf16_t* HID;
    __device__ __forceinline__ void operator()(AccRef acc, const Unit& u, int wr, int wc, int fr, int fq) const {
        const int oc = 128 * u.pn + 32 * wc + 8 * fq;
#pragma unroll
        EPI_ROWS { const int r = 256 * u.pm + EPI_ROW_L; const f32x4 g0 = acc[ai][0][m][0], g1 = acc[ai][0][m][1];
            *(u32x4*)(HID + (size_t)r * 256 + oc) = pack8(g0 * sigm4(g0) * acc[ai][1][m][0], g1 * sigm4(g1) * acc[ai][1][m][1]); }
    } };
struct EpiSwi8 { unsigned char* HID; int row0; float inv;
    __device__ __forceinline__ void operator()(AccRef acc, const Unit& u, int wr, int wc, int fr, int fq) const {
        const int oc = 128 * u.pn + 32 * wc + 8 * fq;
#pragma unroll
        EPI_ROWS { const int r = row0 + 256 * u.pm + EPI_ROW_L; const f32x4 g0 = acc[ai][0][m][0] * inv, g1 = acc[ai][0][m][1] * inv;
            *(u32x2*)(HID + (size_t)r * 256 + oc) = (u32x2){pk4_fp8(g0 * sigm4(g0) * acc[ai][1][m][0], HID_SCALE * inv), pk4_fp8(g1 * sigm4(g1) * acc[ai][1][m][1], HID_SCALE * inv)}; }
    } };
struct EpiShDn { bf16_t* SH;
    __device__ __forceinline__ void operator()(AccRef acc, const Unit& u, int wr, int wc, int fr, int fq) const {
#pragma unroll
        for (int bj = 0; bj < 2; ++bj) { const int c = 256 * u.pn + EPI_COL_L(bj);
#pragma unroll
            EPI_ROWS { *(u32x4*)(SH + (size_t)(256 * u.pm + EPI_ROW_L) * 1024 + c) = pack8(acc[ai][bj][m][0], acc[ai][bj][m][1]); } }
    } };
struct EpiExDn { unsigned char* YS; const LAS unsigned* tab; int dbg = 0;
    __device__ __forceinline__ void operator()(AccRef acc, const Unit& u, int wr, int wc, int fr, int fq) const {
#pragma unroll
        EPI_ROWS { const unsigned w = tab[u.li * 256 + EPI_ROW_L]; const unsigned slot = w & 0x7FFFFu; const float gt = (float)(w >> 19) * ((1.f / 3000.f) * YS_SCALE / (W_SCALE * HID_SCALE));
            u32x4 o;
            if (dbg & 4) o = (u32x4){__float_as_uint(acc[ai][0][m][0].x), __float_as_uint(acc[ai][0][m][1].x), __float_as_uint(acc[ai][1][m][0].x), __float_as_uint(acc[ai][1][m][1].x)};
            else o = (u32x4){pk4_fp8(acc[ai][0][m][0], gt), pk4_fp8(acc[ai][0][m][1], gt), pk4_fp8(acc[ai][1][m][0], gt), pk4_fp8(acc[ai][1][m][1], gt)};
#if P13_NT2
            *(u32x4*)(YS + (size_t)slot * 1024 + 256 * u.pn + 64 * wc + 16 * fq) = o; }
#else
            if (slot < (unsigned)(TOK * TOPK + TOK)) *(u32x4*)(YS + (size_t)slot * 1024 + 256 * u.pn + 64 * wc + 16 * fq) = o; }
#endif
    } };

struct Args { const float* in[32]; float* out; unsigned char* ws; int ph_lo, ph_hi, flags, pad_; };
enum { I_X = 0, I_C, I_WADA, I_BADA, I_WIN, I_BIN, I_LRE, I_LIM, I_LDT, I_BRE, I_BIM, I_CRE, I_CIM, I_S5D, I_WGLU, I_BGLU, I_WF, I_BF, I_WOUT, I_BOUT, I_LN1G, I_LN1B,
       I_WRT, I_RBIAS, I_EG, I_EU, I_ED, I_SHG, I_SHU, I_SHD, I_LN2G, I_LN2B };
struct Frame { LAS unsigned char* lds; int tid, lane, wave, vcu, G; };

__device__ __forceinline__ void transpose_item(const float* W, int K, int N, int k0, int n0, bf16_t* dst, int drow0, LAS unsigned* scr, int lane) {
    const float* src = W + (size_t)k0 * N + n0 + lane;
    float v[64];
#pragma unroll
    for (int i = 0; i < 64; ++i) v[i] = src[(size_t)i * N];
#pragma unroll
    for (int i = 0; i < 32; ++i) scr[i * 65 + lane] = cvt_pk_bf16(v[2 * i], v[2 * i + 1]);
    LDS_WAIT(); asm volatile("" ::: "memory");
    const int c = lane & 7;
#pragma unroll
    for (int j = 0; j < 8; ++j) { const int n = (lane >> 3) + 8 * j; const LAS unsigned* s = scr + (4 * c) * 65 + n;
        u32x4 o; o.x = s[0]; o.y = s[65]; o.z = s[130]; o.w = s[195];
        *(u32x4*)(dst + (size_t)(drow0 + n) * K + k0 + 8 * c) = o; }
    LDS_WAIT(); asm volatile("" ::: "memory");
}
__device__ __forceinline__ void transpose_item_f8(const float* W, int K, int N, int k0, int n0, unsigned char* dst, int drow0, LAS unsigned* scr, int lane, float scale) {
    const float* src = W + (size_t)k0 * N + n0 + lane;
#pragma unroll
    for (int hf = 0; hf < 2; ++hf) { float v[64];
#pragma unroll
        for (int i = 0; i < 64; ++i) v[i] = src[(size_t)(hf * 64 + i) * N];
#pragma unroll
        for (int i = 0; i < 16; ++i) scr[(hf * 16 + i) * 65 + lane] = pk4_fp8((f32x4){v[4 * i], v[4 * i + 1], v[4 * i + 2], v[4 * i + 3]}, scale); }
    LDS_WAIT(); asm volatile("" ::: "memory");
    const int c = lane & 7;
#pragma unroll
    for (int j = 0; j < 8; ++j) { const int n = (lane >> 3) + 8 * j; const LAS unsigned* q = scr + (4 * c) * 65 + n;
        u32x4 o; o.x = q[0]; o.y = q[65]; o.z = q[130]; o.w = q[195];
        *(u32x4*)(dst + (size_t)(drow0 + n) * K + k0 + 16 * c) = o; }
    LDS_WAIT(); asm volatile("" ::: "memory");
}
__device__ __forceinline__ void s5_matrices(const Frame& F, const Args& a, int g, int sl, bf16_t* MB, bf16_t* TC) {
    LAS float* L = (LAS float*)F.lds;
    LAS float* pwr = L;
    LAS float* pwi = L + 2176;
    LAS float* bbr = L + 4352;
    LAS float* bbi = L + 6400;
    LAS float* cr = L + 8448;
    LAS float* ci = L + 10496;
    LAS float* Kd = L + 12544;
    LAS float* prm = L + 20736;
    const int tid = F.tid;
    __syncthreads();
    if (tid < 128) { const int d = tid >> 6, p = tid & 63; prm[tid] = a.in[I_LRE][(d * NGRP + g) * 64 + p]; prm[128 + tid] = a.in[I_LIM][(d * NGRP + g) * 64 + p]; }
    else if (tid < 130) prm[256 + tid - 128] = expf(a.in[I_LDT][(tid - 128) * NGRP + g]);
    else if (tid < 146) prm[272 + tid - 130] = a.in[I_S5D][g * 16 + tid - 130];
    __syncthreads();
    for (int idx = tid; idx < 2 * 17 * 64; idx += 512) { const int d = idx / (17 * 64), e = (idx / 64) % 17, p = idx % 64;
        const float lr = prm[d * 64 + p], li = prm[128 + d * 64 + p], dt = prm[256 + d];
        const float mg = __expf(lr * dt * (float)e); float sn, cs; fast_sincos(li * dt * (float)e, sn, cs);
        pwr[idx] = mg * cs; pwi[idx] = mg * sn; }
    for (int idx = tid; idx < 2 * 64 * 16; idx += 512) { const int d = idx / 1024, p = (idx / 16) % 64, h = idx % 16;
        const float lr = prm[d * 64 + p], li = prm[128 + d * 64 + p], dt = prm[256 + d];
        const float mg = __expf(lr * dt); float sn, cs; fast_sincos(li * dt, sn, cs);
        const float abr = mg * cs, abi = mg * sn, den = lr * lr + li * li, nr = abr - 1.f;
        const float cfr = (nr * lr + abi * li) / den, cfi = (abi * lr - nr * li) / den;
        const size_t bo = ((size_t)(d * NGRP + g) * 64 + p) * 16 + h; const float br = a.in[I_BRE][bo], bi = a.in[I_BIM][bo];
        bbr[idx] = cfr * br - cfi * bi; bbi[idx] = cfr * bi + cfi * br; }
    for (int idx = tid; idx < 2 * 16 * 64; idx += 512) { const int d = idx / 1024, r = idx % 1024, h = r >> 6, p = r & 63;
        const size_t co = (size_t)(d * NGRP + g) * 1024 + r; cr[(d * 64 + p) * 16 + h] = a.in[I_CRE][co]; ci[(d * 64 + p) * 16 + h] = a.in[I_CIM][co]; }
    __syncthreads();
    {   const int d = tid >> 8, dl = (tid >> 4) & 15, h = tid & 15; float acc16[16];
#pragma unroll
        for (int q = 0; q < 16; ++q) acc16[q] = 0.f;
        for (int p = 0; p < 64; ++p) { const float wr_ = pwr[(d * 17 + dl) * 64 + p], wi_ = pwi[(d * 17 + dl) * 64 + p], c_r = cr[(d * 64 + p) * 16 + h], c_i = ci[(d * 64 + p) * 16 + h];
            const float qr = c_r * wr_ - c_i * wi_, qi = c_r * wi_ + c_i * wr_;
#pragma unroll
            for (int q4 = 0; q4 < 4; ++q4) { const f32x4 br = *(const LAS f32x4*)(bbr + (d * 64 + p) * 16 + 4 * q4), bi = *(const LAS f32x4*)(bbi + (d * 64 + p) * 16 + 4 * q4);
                acc16[4 * q4 + 0] += qr * br.x - qi * bi.x; acc16[4 * q4 + 1] += qr * br.y - qi * bi.y; acc16[4 * q4 + 2] += qr * br.z - qi * bi.z; acc16[4 * q4 + 3] += qr * br.w - qi * bi.w; } }
#pragma unroll
        for (int q = 0; q < 16; ++q) Kd[((d * 16 + dl) * 16 + h) * 16 + q] = acc16[q]; }
    __syncthreads();
    for (int idx = tid; idx < 32 * 128; idx += 512) { const int n = 32 * sl + idx / 128, k = (idx % 128) * 2; const int d = n >> 7, part = (n >> 6) & 1, p = n & 63, j = k >> 4, hp = k & 15;
        const int e = d == 0 ? 15 - j : j; const float wr_ = pwr[(d * 17 + e) * 64 + p], wi_ = pwi[(d * 17 + e) * 64 + p];
        float v[2];
#pragma unroll
        for (int q = 0; q < 2; ++q) { const float br = bbr[(d * 64 + p) * 16 + hp + q], bi = bbi[(d * 64 + p) * 16 + hp + q]; v[q] = part == 0 ? wr_ * br - wi_ * bi : wr_ * bi + wi_ * br; }
        *(unsigned*)(MB + (size_t)n * 256 + k) = cvt_pk_bf16(v[0], v[1]); }
    for (int idx = tid; idx < 32 * 256; idx += 512) { const int n = 32 * sl + idx / 256, k = (idx % 256) * 2; const int i = n >> 4, h = n & 15; float v[2];
        if (k < 256) { const int j = k >> 4, hp = k & 15;
#pragma unroll
            for (int q = 0; q < 2; ++q) { float s = 0.f; if (i >= j) s += Kd[((0 * 16 + (i - j)) * 16 + h) * 16 + hp + q]; if (j >= i) s += Kd[((1 * 16 + (j - i)) * 16 + h) * 16 + hp + q];
                if (i == j && h == hp + q) s += prm[272 + h]; v[q] = s; } }
        else { const int kk = k - 256, d = kk >> 7, part = (kk >> 6) & 1, p0 = kk & 63; const int e = d == 0 ? i + 1 : 16 - i;
#pragma unroll
            for (int q = 0; q < 2; ++q) { const int p = p0 + q; const float wr_ = pwr[(d * 17 + e) * 64 + p], wi_ = pwi[(d * 17 + e) * 64 + p], c_r = cr[(d * 64 + p) * 16 + h], c_i = ci[(d * 64 + p) * 16 + h];
                v[q] = part == 0 ? (c_r * wr_ - c_i * wi_) : -(c_r * wi_ + c_i * wr_); } }
        *(unsigned*)(TC + (size_t)n * 512 + k) = cvt_pk_bf16(v[0], v[1]); }
    __syncthreads();
}
__device__ __forceinline__ void fourier_weight_item(const Frame& F, const float* Wf, unsigned char* WFP, int item) {
    LAS float* wl = (LAS float*)F.lds;
    LAS float* ct = wl + 2048;
    const int g4 = item >> 6, n0 = (item & 63) * 16, tid = F.tid;
    __syncthreads();
    { const int l = tid >> 2, n = (tid & 3) * 4; *(LAS f32x4*)(wl + l * 16 + n) = *(const f32x4*)(Wf + (size_t)(g4 * 128 + l) * 1024 + n0 + n); }
    if (tid < 128) ct[tid] = cospif((float)tid * (1.f / 64.f));
    __syncthreads();
    const float scale = 1.f / 724.0773439350247f;
    const int pw = tid & 255, part = pw >> 7, w = pw & 127, nh = tid >> 8;
    f32x4 a0 = {0.f, 0.f, 0.f, 0.f}, a1 = {0.f, 0.f, 0.f, 0.f};
    for (int l = 0; l < 128; ++l) { const int ph = (l * w) & 127; const float tr = part == 0 ? ct[ph] : -ct[(ph + 96) & 127];
        a0 += tr * *(const LAS f32x4*)(wl + l * 16 + nh * 8); a1 += tr * *(const LAS f32x4*)(wl + l * 16 + nh * 8 + 4); }
    unsigned char* o = WFP + (size_t)(n0 + nh * 8) * 1024 + part * 512 + g4 * 128 + w;
    const unsigned q0 = pk4_fp8(a0, scale * WFP_SCALE), q1 = pk4_fp8(a1, scale * WFP_SCALE);
    o[0 * 1024] = (unsigned char)(q0 & 0xffu); o[1 * 1024] = (unsigned char)((q0 >> 8) & 0xffu); o[2 * 1024] = (unsigned char)((q0 >> 16) & 0xffu); o[3 * 1024] = (unsigned char)(q0 >> 24);
    o[4 * 1024] = (unsigned char)(q1 & 0xffu); o[5 * 1024] = (unsigned char)((q1 >> 8) & 0xffu); o[6 * 1024] = (unsigned char)((q1 >> 16) & 0xffu); o[7 * 1024] = (unsigned char)(q1 >> 24);
    __syncthreads();
}

__device__ __forceinline__ void p0_prologue(const Frame& F, const Args& a, const int part) {
    unsigned char* ws = a.ws;
    const int gw = F.vcu * 8 + F.wave, NGW = F.G * 8;
    if (part & 4) {
    for (int it = F.vcu; it < NGRP * 8; it += F.G) s5_matrices(F, a, it >> 3, it & 7, (bf16_t*)(ws + WS_S5MB) + (size_t)(it >> 3) * 65536, (bf16_t*)(ws + WS_S5TC) + (size_t)(it >> 3) * 131072);
    }
    if (part & 8) {
    for (int it = F.vcu; it < 256; it += F.G) fourier_weight_item(F, a.in[I_WF], ws + WS_WFP, it);
    }
    if (part & 16) {
    {   bf16_t* TB = (bf16_t*)(ws + WS_DFT);
        const int nth = F.G * 512, me = F.vcu * 512 + F.tid;
        for (int q = me; q < 16 * 512 * 64; q += nth) { const int k1 = q >> 15, m = (q >> 6) & 511, K0 = (q & 63) * 8, prt = m >> 8, k2 = m & 255, yp = K0 >> 8, s20 = K0 & 255, k = k1 + 16 * k2; float v[8];
#pragma unroll
            for (int e = 0; e < 8; ++e) { const float rev = (float)((k * (s20 + e)) & 4095) * (1.f / 4096.f); const float fr = __builtin_amdgcn_cosf(rev), fs = __builtin_amdgcn_sinf(rev); v[e] = prt == 0 ? (yp == 0 ? fr : fs) : (yp == 0 ? fs : -fr); }
            *(u32x4*)(TB + (size_t)(k1 * 512 + m) * 512 + K0) = (u32x4){cvt_pk_bf16(v[0], v[1]), cvt_pk_bf16(v[2], v[3]), cvt_pk_bf16(v[4], v[5]), cvt_pk_bf16(v[6], v[7])}; }
    }
    }
    if (!(part & 2)) return;
    LAS unsigned* scr = (LAS unsigned*)(F.lds + F.wave * 8448);
    LAS float* sc = (LAS float*)(F.lds + 69632);
    LAS int* ctr = (LAS int*)(F.lds + 69632 + 32768);
    __syncthreads();
    for (int i = F.tid; i < 8192; i += 512) { const float v = a.in[I_C][i]; sc[(i & 1023) * 8 + (i >> 10)] = v * sigm(v); }
    if (F.tid == 0) *ctr = 0;
    __syncthreads();
    constexpr int IT_WIN = 8 * 48, IT_GLU = 4 * 32, IT_OUT = 8 * 16, IT_RT = 16 * 4, IT_SH = 8 * 4, IT_SHD = 2 * 16, IT_SMALL = IT_WIN + IT_GLU + IT_OUT + IT_RT + 2 * IT_SH + IT_SHD;
    constexpr int IT_ALL = IT_SMALL, IT_ADA = 96 * 8;
    const int a_lo = (int)((long long)IT_ADA * F.vcu / F.G), n_ada = (int)((long long)IT_ADA * (F.vcu + 1) / F.G) - a_lo;
    const int t_lo = (int)((long long)IT_ALL * F.vcu / F.G), n_loc = n_ada + (int)((long long)IT_ALL * (F.vcu + 1) / F.G) - t_lo;
    float* modp = (float*)(ws + WS_MODP);
    for (;;) {
        int li = 0; if (F.lane == 0) li = __hip_atomic_fetch_add(ctr, 1, __ATOMIC_RELAXED, __HIP_MEMORY_SCOPE_WORKGROUP);
        li = __builtin_amdgcn_readfirstlane(li);
        if (li >= n_loc) break;
        if (li < n_ada) { const int it = a_lo + li, cb = it % 96, kc = it / 96, j = cb * 64 + F.lane; f32x4 s0 = {0.f, 0.f, 0.f, 0.f}, s1 = {0.f, 0.f, 0.f, 0.f};
            const float* wp = a.in[I_WADA] + (size_t)(kc * 128) * 6144 + j;
#pragma unroll 32
            for (int k = 0; k < 128; ++k) { const float w = wp[(size_t)k * 6144]; s0 += w * *(const LAS f32x4*)(sc + (kc * 128 + k) * 8); s1 += w * *(const LAS f32x4*)(sc + (kc * 128 + k) * 8 + 4); }
#pragma unroll
            for (int b = 0; b < 4; ++b) { modp[(size_t)(kc * 8 + b) * 6144 + j] = s0[b]; modp[(size_t)(kc * 8 + 4 + b) * 6144 + j] = s1[b]; }
            continue; }
        int r = t_lo + (li - n_ada);
        if (r < IT_WIN) { const int kb = r / 48, nb = r % 48; transpose_item_f8(a.in[I_WIN], 1024, 3072, kb * 128, nb * 64, ws + WS_WIN, nb * 64, scr, F.lane, W_SCALE); continue; } r -= IT_WIN;
        if (r < IT_GLU) { const int kb = r / 32, nb = r % 32, n0 = nb * 64; const int dr = n0 < 1024 ? (n0 >> 7) * 256 + (n0 & 127) : ((n0 - 1024) >> 7) * 256 + 128 + (n0 & 127);
            transpose_item_f8(a.in[I_WGLU], 512, 2048, kb * 128, n0, ws + WS_WGLU, dr, scr, F.lane, W_SCALE); continue; } r -= IT_GLU;
        if (r < IT_OUT) { const int kb = r / 16, nb = r % 16; transpose_item_f8(a.in[I_WOUT], 1024, 1024, kb * 128, nb * 64, ws + WS_WOUT, nb * 64, scr, F.lane, W_SCALE); continue; } r -= IT_OUT;
        if (r < IT_RT) { const int kb = r / 4, nb = r % 4; transpose_item(a.in[I_WRT], 1024, 256, kb * 64, nb * 64, (bf16_t*)(ws + WS_WRT), nb * 64, scr, F.lane); continue; } r -= IT_RT;
        if (r < 2 * IT_SH) { const int up = r / IT_SH, q = r % IT_SH, kb = q / 4, nb = q % 4, n0 = nb * 64;
            transpose_item_f8(a.in[up ? I_SHU : I_SHG], 1024, 256, kb * 128, n0, ws + WS_WSHGU, (n0 >> 7) * 256 + up * 128 + (n0 & 127), scr, F.lane, W_SCALE); continue; } r -= 2 * IT_SH;
        if (r < IT_SHD) { const int kb = r / 16, nb = r % 16; transpose_item_f8(a.in[I_SHD], 256, 1024, kb * 128, nb * 64, ws + WS_EDN + (size_t)NEXP * 262144, nb * 64, scr, F.lane, W_SCALE); continue; } r -= IT_SHD;
    }
    __syncthreads();
    {   constexpr int NIT = NEXP * 3 * 8;
        const int lo = (int)((long long)NIT * F.vcu / F.G), hi = (int)((long long)NIT * (F.vcu + 1) / F.G);
        const int w = F.wave, l = F.lane;
        auto ld = [&](f32x4 (&v)[16], int idx) { const float* src; int ldn;
            if (idx < NEXP * 16) { const int mat = idx >> 3, kb = idx & 7; src = a.in[(mat & 1) ? I_EU : I_EG] + (size_t)(mat >> 1) * 262144 + (size_t)kb * 128 * 256; ldn = 256; }
            else { const int j = idx - NEXP * 16, e = j >> 3, kb = (j >> 2) & 1, nb = j & 3; src = a.in[I_ED] + (size_t)e * 262144 + (size_t)kb * 128 * 1024 + nb * 256; ldn = 1024; }
            src += (size_t)(16 * w) * ldn + 4 * l;
#pragma unroll
            for (int i = 0; i < 16; ++i) v[i] = *(const f32x4*)(src + (size_t)i * ldn); };
        auto cw = [&](const f32x4 (&v)[16], LAS unsigned char* buf) {
#pragma unroll
            for (int q = 0; q < 4; ++q) { u32x4 o;
#pragma unroll
                for (int cq = 0; cq < 4; ++cq) o[cq] = pk4_fp8((f32x4){v[4 * cq][q], v[4 * cq + 1][q], v[4 * cq + 2][q], v[4 * cq + 3][q]}, W_SCALE);
                *(LAS u32x4*)(buf + (l + 64 * q) * 128 + ((w ^ ((l >> 1) & 7)) << 4)) = o; } };
        auto rs = [&](int idx, const LAS unsigned char* buf) { unsigned char* dst; int gu;
            if (idx < NEXP * 16) { const int mat = idx >> 3, kb = idx & 7; dst = ws + WS_EGU + (size_t)(mat >> 1) * 524288 + (size_t)((mat & 1) * 128) * 1024 + kb * 128; gu = 1; }
            else { const int j = idx - NEXP * 16, e = j >> 3, kb = (j >> 2) & 1, nb = j & 3; dst = ws + WS_EDN + (size_t)e * 262144 + (size_t)(nb * 256) * 256 + kb * 128; gu = 0; }
#pragma unroll
            for (int pq = 0; pq < 4; ++pq) { const int pos = w * 32 + pq * 8 + (l >> 3), cq = l & 7, n = 4 * (pos & 63) + (pos >> 6);
                const u32x4 v = *(const LAS u32x4*)(buf + pos * 128 + ((cq ^ ((pos >> 1) & 7)) << 4));
                const size_t ro = gu ? (size_t)((n >> 7) * 256 + (n & 127)) * 1024 : (size_t)n * 256;
                *(u32x4*)(dst + ro + 16 * cq) = v; } };
        LAS unsigned char* b0 = F.lds; LAS unsigned char* b1 = F.lds + 32768;
        f32x4 va[16], vb[16];
        if (lo < hi) ld(va, lo);
        for (int it = lo; it < hi; it += 2) {
            CFENCE(); if (it + 1 < hi) ld(vb, it + 1); CFENCE();
            cw(va, b0); __syncthreads(); rs(it, b0);
            CFENCE(); if (it + 2 < hi) ld(va, it + 2); CFENCE();
            if (it + 1 < hi) { cw(vb, b1); __syncthreads(); rs(it + 1, b1); }
        }
        __syncthreads();
    }
}

__device__ __forceinline__ void p1_load(f32x4 (&v)[4][4], const float* X, const int t0, const int lane) {
#pragma unroll
    for (int q = 0; q < 4; ++q) { const f32x4* xr = (const f32x4*)(X + (size_t)(t0 + q) * 1024) + lane;
#pragma unroll
        for (int j = 0; j < 4; ++j) v[q][j] = xr[64 * j]; }
}
__device__ __forceinline__ void p1_proc(f32x4 (&v)[4][4], unsigned char* U8, const LAS float* sh, const int t0, const int lane) {
#pragma unroll
    for (int q = 0; q < 4; ++q) { const int t = t0 + q; float s = 0.f;
#pragma unroll
        for (int j = 0; j < 4; ++j) s += (v[q][j].x + v[q][j].y) + (v[q][j].z + v[q][j].w);
        const float mean = wave_sum(s) * (1.f / 1024.f); float s2 = 0.f;
#pragma unroll
        for (int j = 0; j < 4; ++j) { v[q][j] = v[q][j] - mean; s2 += (v[q][j].x * v[q][j].x + v[q][j].y * v[q][j].y) + (v[q][j].z * v[q][j].z + v[q][j].w * v[q][j].w); }
        const float rstd = 1.f / sqrtf(wave_sum(s2) * (1.f / 1024.f) + LN_EPS);
        unsigned* o4 = (unsigned*)(U8 + (size_t)t * 1024) + lane;
#pragma unroll
        for (int j = 0; j < 4; ++j) { const int c = 4 * lane + 256 * j; const f32x4 s1 = *(const LAS f32x4*)(sh + c), c1 = *(const LAS f32x4*)(sh + 1024 + c);
            const f32x4 y = v[q][j] * rstd * (c1 + 1.f) + s1; o4[64 * j] = pk4_fp8(y, U_SCALE); } }
}
__device__ __forceinline__ void p1_modulate(const Frame& F, const Args& a) {
    unsigned char* ws = a.ws; const float* modp = (const float*)(ws + WS_MODP); float* mod = (float*)(ws + WS_MOD);
    const int tb = F.vcu * 128 + F.wave * 4; const float* X = a.in[I_X];
    f32x4 va[4][4], vb[4][4];
    p1_load(va, X, tb, F.lane); p1_load(vb, X, tb + 32, F.lane); CFENCE();
    if (F.tid < 192) { const int i = F.vcu * 192 + F.tid, b = i / 6144, j = i % 6144; float s = a.in[I_BADA][j];
#pragma unroll
        for (int kc = 0; kc < 8; ++kc) s += modp[(size_t)(kc * 8 + b) * 6144 + j];
        mod[i] = s; }
    LAS float* sh = (LAS float*)F.lds; const int b = F.vcu >> 5;
    __syncthreads();
    for (int j = F.tid; j < 2048; j += 512) { float s = a.in[I_BADA][j];
#pragma unroll
        for (int kc = 0; kc < 8; ++kc) s += modp[(size_t)(kc * 8 + b) * 6144 + j];
        sh[j] = s; }
    __syncthreads();
    unsigned char* U8 = ws + WS_U;
    CFENCE(); p1_proc(va, U8, sh, tb, F.lane); CFENCE(); p1_load(va, X, tb + 64, F.lane); CFENCE();
    p1_proc(vb, U8, sh, tb + 32, F.lane); CFENCE(); p1_load(vb, X, tb + 96, F.lane); CFENCE();
    p1_proc(va, U8, sh, tb + 64, F.lane); CFENCE();
    p1_proc(vb, U8, sh, tb + 96, F.lane);
    __syncthreads();
}

__device__ __forceinline__ void s5_scan(const Frame& F, const Args& a) {
    unsigned char* ws = a.ws; const bf16_t* Sg = (const bf16_t*)(ws + WS_S); bf16_t* UX = (bf16_t*)(ws + WS_UX);
    LAS float* xs = (LAS float*)F.lds;
    const int set = F.wave >> 2, seg = F.wave & 3, p = F.lane;
    for (int it = 0; it * F.G * 2 < NGRP * NB * 2; ++it) {
        const int trip = (it * F.G + F.vcu) * 2 + set; const bool live = trip < NGRP * NB * 2;
        const int g = trip >> 4, b = (trip >> 1) & 7, d = trip & 1;
        float sr[64], si[64];
        float Ar = 0.f, Ai = 0.f;
        if (live) {
            const float lr = a.in[I_LRE][(d * NGRP + g) * 64 + p], li = a.in[I_LIM][(d * NGRP + g) * 64 + p], dt = expf(a.in[I_LDT][d * NGRP + g]);
            const float mg = expf(lr * dt * 16.f); float sn, cs; sincosf(li * dt * 16.f, &sn, &cs); Ar = mg * cs; Ai = mg * sn;
            const bf16_t* base = Sg + ((size_t)g * 2048 + b * 256) * 256 + d * 128 + p;
#pragma unroll
            for (int q = 0; q < 64; ++q) { const int c = d == 0 ? seg * 64 + q : 255 - (seg * 64 + q); sr[q] = bf_lo((unsigned)base[(size_t)c * 256]); si[q] = bf_lo((unsigned)base[(size_t)c * 256 + 64]); }
        } else {
#pragma unroll
            for (int q = 0; q < 64; ++q) { sr[q] = 0.f; si[q] = 0.f; }
        }
        float lr_ = 0.f, li_ = 0.f;
#pragma unroll
        for (int q = 0; q < 64; ++q) { const float nr = Ar * lr_ - Ai * li_ + sr[q], ni = Ar * li_ + Ai * lr_ + si[q]; lr_ = nr; li_ = ni; sr[q] = nr; si[q] = ni; }
        __syncthreads();
        xs[((set * 4 + seg) * 64 + p) * 2] = lr_; xs[((set * 4 + seg) * 64 + p) * 2 + 1] = li_;
        __syncthreads();
        float Pr = Ar, Pi = Ai;
#pragma unroll
        for (int s = 0; s < 6; ++s) { const float nr = Pr * Pr - Pi * Pi, ni = 2.f * Pr * Pi; Pr = nr; Pi = ni; }
        float cr_ = 0.f, ci_ = 0.f;
        for (int s = 0; s < seg; ++s) { const float tr = xs[((set * 4 + s) * 64 + p) * 2], ti = xs[((set * 4 + s) * 64 + p) * 2 + 1];
            const float nr = Pr * cr_ - Pi * ci_ + tr, ni = Pr * ci_ + Pi * cr_ + ti; cr_ = nr; ci_ = ni; }
        if (live) {
            bf16_t* ob = UX + ((size_t)g * 2048 + b * 256) * 512 + 256 + d * 128 + p;
            float wr_ = cr_, wi_ = ci_, pr_ = 0.f, pi_ = 0.f;
#pragma unroll
            for (int q = 0; q < 64; ++q) { const int c = d == 0 ? seg * 64 + q : 255 - (seg * 64 + q);
                const float orr = pr_ + wr_, oii = pi_ + wi_;
                ob[(size_t)c * 512] = (bf16_t)(cvt_pk_bf16(orr, 0.f) & 0xffffu); ob[(size_t)c * 512 + 64] = (bf16_t)(cvt_pk_bf16(oii, 0.f) & 0xffffu);
                pr_ = sr[q]; pi_ = si[q]; const float nr = Ar * wr_ - Ai * wi_, ni = Ar * wi_ + Ai * wr_; wr_ = nr; wi_ = ni; }
        }
        __syncthreads();
    }
}

typedef float f32x16 __attribute__((ext_vector_type(16)));
__device__ __forceinline__ void fourier_stage1(const Frame& F, const Args& a) {
    const bf16_t* UFT = (const bf16_t*)(a.ws + WS_UFT); bf16_t* YT = (bf16_t*)(a.ws + WS_YT);
    const int r = F.lane & 31, h = F.lane >> 5, k1 = r & 15, yp = r >> 4;
    float av[8];
#pragma unroll
    for (int j = 0; j < 8; ++j) { const float x = (float)((k1 * (8 * h + j)) & 15) * 0.125f; av[j] = yp == 0 ? cospif(x) : -sinpif(x); }
    const u32x4 au = {cvt_pk_bf16(av[0], av[1]), cvt_pk_bf16(av[2], av[3]), cvt_pk_bf16(av[4], av[5]), cvt_pk_bf16(av[6], av[7])};
    const bf16x8 af = __builtin_bit_cast(bf16x8, au);
    const int gw = F.vcu * 8 + F.wave, NGW = F.G * 8;
    LAS bf16_t* tile = (LAS bf16_t*)(F.lds + F.wave * 8192);
    constexpr int NST1 = NB * 512 * 2;
    auto ld = [&](unsigned short (&x)[32], int st) { const int q4 = st & 1, ch = (st >> 1) & 511, b = st >> 10;
#pragma unroll
        for (int q = 0; q < 4; ++q) { const bf16_t* src = UFT + (size_t)ch * TOK + b * SEQ + 256 * (8 * h) + 128 * q4 + 32 * q + r;
#pragma unroll
            for (int j = 0; j < 8; ++j) x[q * 8 + j] = (unsigned short)src[256 * j]; } };
    auto proc = [&](const unsigned short (&x)[32], int st) { const int q4 = st & 1, ch = (st >> 1) & 511, b = st >> 10;
#pragma unroll
        for (int q = 0; q < 4; ++q) { f32x16 c; bf16x8 xb;
#pragma unroll
            for (int j = 0; j < 8; ++j) xb[j] = (short)x[q * 8 + j];
#pragma unroll
            for (int i = 0; i < 16; ++i) c[i] = 0.f;
            c = __builtin_amdgcn_mfma_f32_32x32x16_bf16(af, xb, c, 0, 0, 0);
#pragma unroll
            for (int i = 0; i < 16; ++i) { const int m = (i & 3) + 8 * (i >> 2) + 4 * h; tile[m * 128 + 32 * q + r] = (bf16_t)(cvt_pk_bf16(c[i], 0.f) & 0xffffu); } }
        LDS_WAIT(); asm volatile("" ::: "memory");
#pragma unroll
        for (int p = 0; p < 8; ++p) { const int chunk = p * 64 + F.lane, m = chunk >> 4, cc = chunk & 15;
            const u32x4 v = *(const LAS u32x4*)(tile + m * 128 + cc * 8);
            *(u32x4*)(YT + ((size_t)(b * 16 + (m & 15)) * 512 + ch) * 512 + (m >> 4) * 256 + 128 * q4 + cc * 8) = v; }
        LDS_WAIT(); asm volatile("" ::: "memory"); };
    unsigned short xa[32], xc[32];
    if (gw < NST1) ld(xa, gw);
    for (int st = gw; st < NST1; st += 2 * NGW) {
        CFENCE(); if (st + NGW < NST1) ld(xc, st + NGW); CFENCE();
        proc(xa, st);
        CFENCE(); if (st + 2 * NGW < NST1) ld(xa, st + 2 * NGW); CFENCE();
        if (st + NGW < NST1) proc(xc, st + NGW);
    }
}
struct SchedDft2 : SchedDense {
    __device__ __forceinline__ const char* a_base(const Unit& u) const { return A + (size_t)(u.z & 15) * zA + (size_t)u.pm * 256 * lda; }
};
struct EpiZc2 { unsigned char* ZC;
    __device__ __forceinline__ void operator()(AccRef acc, const Unit& u, int wr, int wc, int fr, int fq) const {
#pragma unroll
        for (int bj = 0; bj < 2; ++bj) { const int c = u.pm * 512 + 256 * u.pn + EPI_COL_L(bj);
#pragma unroll
            EPI_ROWS { const int t = (u.z >> 4) * SEQ + (u.z & 15) + 16 * EPI_ROW_L;
                *(u32x2*)(ZC + (size_t)t * 1024 + c) = (u32x2){pk4_fp8(acc[ai][bj][m][0], ZC_SCALE), pk4_fp8(acc[ai][bj][m][1], ZC_SCALE)}; } }
    } };

__device__ __forceinline__ void p8_load(u32x4 (&w)[4][2], const bf16_t* R1, const int t0, const int lane) {
#pragma unroll
    for (int q = 0; q < 4; ++q)
#pragma unroll
        for (int j = 0; j < 2; ++j) w[q][j] = *(const u32x4*)(R1 + (size_t)(t0 + q) * 1024 + 8 * lane + 512 * j);
}
__device__ __forceinline__ void p8_proc(u32x4 (&w)[4][2], bf16_t* X1, bf16_t* H, unsigned char* H8, const LAS f32x4* cst, const int t0, const int lane) {
#pragma unroll
    for (int q = 0; q < 4; ++q) { const int t = t0 + q; f32x4 v[4]; float s = 0.f;
#pragma unroll
        for (int j = 0; j < 2; ++j) { unpack8(w[q][j], v[2 * j], v[2 * j + 1]); s += (v[2 * j].x + v[2 * j].y) + (v[2 * j].z + v[2 * j].w) + (v[2 * j + 1].x + v[2 * j + 1].y) + (v[2 * j + 1].z + v[2 * j + 1].w); }
        float mean = wave_sum(s) * (1.f / 1024.f), s2 = 0.f;
#pragma unroll
        for (int j = 0; j < 4; ++j) { v[j] = v[j] - mean; s2 += (v[j].x * v[j].x + v[j].y * v[j].y) + (v[j].z * v[j].z + v[j].w * v[j].w); }
        float rstd = 1.f / sqrtf(wave_sum(s2) * (1.f / 1024.f) + LN_EPS);
        s = 0.f;
#pragma unroll
        for (int j = 0; j < 4; ++j) { v[j] = v[j] * rstd * cst[(0 * 4 + j) * 64 + lane] + cst[(1 * 4 + j) * 64 + lane]; s += (v[j].x + v[j].y) + (v[j].z + v[j].w); }
        mean = wave_sum(s) * (1.f / 1024.f); s2 = 0.f;
#pragma unroll
        for (int j = 0; j < 4; ++j) { v[j] = v[j] - mean; s2 += (v[j].x * v[j].x + v[j].y * v[j].y) + (v[j].z * v[j].z + v[j].w * v[j].w); }
        rstd = 1.f / sqrtf(wave_sum(s2) * (1.f / 1024.f) + LN_EPS);
#pragma unroll
        for (int j = 0; j < 4; ++j) v[j] = v[j] * rstd * cst[(3 * 4 + j) * 64 + lane] + cst[(2 * 4 + j) * 64 + lane];
#pragma unroll
        for (int j = 0; j < 2; ++j) { *(u32x4*)(H + (size_t)t * 1024 + 8 * lane + 512 * j) = pack8(v[2 * j], v[2 * j + 1]);
            *(u32x2*)(H8 + (size_t)t * 1024 + 8 * lane + 512 * j) = (u32x2){pk4_fp8(v[2 * j], H_SCALE), pk4_fp8(v[2 * j + 1], H_SCALE)}; } }
}
__device__ __forceinline__ void p8_ln1(const Frame& F, const Args& a) {
    unsigned char* ws = a.ws; const bf16_t* R1 = (const bf16_t*)(ws + WS_R1); bf16_t* X1 = (bf16_t*)(ws + WS_X1); bf16_t* H = (bf16_t*)(ws + WS_H); unsigned char* H8 = ws + WS_H8; const float* mod = (const float*)(ws + WS_MOD);
    const int b = F.vcu >> 5, tb = F.vcu * 128 + F.wave * 4;
    u32x4 wa[4][2], wb[4][2], wc[4][2];
    p8_load(wa, R1, tb, F.lane); p8_load(wb, R1, tb + 32, F.lane); p8_load(wc, R1, tb + 64, F.lane); CFENCE();
    LAS f32x4* cst = (LAS f32x4*)F.lds;
    __syncthreads();
    if (F.tid < 256) { const int j = F.tid >> 6, l = F.tid & 63, c = 8 * l + 512 * (j >> 1) + 4 * (j & 1);
        cst[(0 * 4 + j) * 64 + l] = *(const f32x4*)(a.in[I_LN1G] + c); cst[(1 * 4 + j) * 64 + l] = *(const f32x4*)(a.in[I_LN1B] + c);
        cst[(2 * 4 + j) * 64 + l] = *(const f32x4*)(mod + b * 6144 + 3072 + c); cst[(3 * 4 + j) * 64 + l] = *(const f32x4*)(mod + b * 6144 + 4096 + c) + 1.f; }
    __syncthreads();
    CFENCE(); p8_proc(wa, X1, H, H8, cst, tb, F.lane); CFENCE(); p8_load(wa, R1, tb + 96, F.lane); CFENCE();
    p8_proc(wb, X1, H, H8, cst, tb + 32, F.lane); CFENCE();
    p8_proc(wc, X1, H, H8, cst, tb + 64, F.lane); CFENCE();
    p8_proc(wa, X1, H, H8, cst, tb + 96, F.lane);
    __syncthreads();
}

__device__ __forceinline__ void p10_route(const Frame& F, const Args& a) {
    unsigned char* ws = a.ws; const float* LG = (const float*)(ws + WS_LOGITS); int* eidx = (int*)(ws + WS_EIDX); float* gatev = (float*)(ws + WS_GATE);
    LAS float* sel = (LAS float*)F.lds;
    LAS int* le = (LAS int*)(F.lds + LDSCTL_OFF + 2048);
    const float* rb = a.in[I_RBIAS];
    __syncthreads();
    {   f32x4 lgv[16]; const f32x4 bb = *(const f32x4*)(rb + (F.tid & 63) * 4);
#pragma unroll
        for (int k = 0; k < 16; ++k) lgv[k] = *(const f32x4*)(LG + (size_t)(F.vcu * 128 + (F.tid >> 6) + 8 * k) * 256 + (F.tid & 63) * 4);
#pragma unroll
        for (int k = 0; k < 16; ++k) { const int r = (F.tid >> 6) + 8 * k, e0 = (F.tid & 63) * 4; const f32x4 lg = lgv[k];
            sel[r * 256 + ((e0 + 0 + r) & 255)] = sigm(lg.x) + bb.x; sel[r * 256 + ((e0 + 1 + r) & 255)] = sigm(lg.y) + bb.y;
            sel[r * 256 + ((e0 + 2 + r) & 255)] = sigm(lg.z) + bb.z; sel[r * 256 + ((e0 + 3 + r) & 255)] = sigm(lg.w) + bb.w; } }
    __syncthreads();
    LAS int* hist = le + 1024;
    if (F.tid < NEXP) hist[F.tid] = 0;
    {
        const int r = F.tid >> 2, prt = F.tid & 3, t = F.vcu * 128 + r, lb = F.lane & ~3; const LAS float* row = sel + r * 256;
        float gl[2];
#pragma unroll
        for (int g2 = 0; g2 < 2; ++g2) { const int gi = prt * 2 + g2; float m1 = -INFINITY, m2 = -INFINITY;
            for (int j = 0; j < 32; ++j) { const float v = row[(gi * 32 + j + r) & 255]; const float n2 = fmaxf(m2, fminf(m1, v)); m1 = fmaxf(m1, v); m2 = n2; }
            gl[g2] = m1 + m2; }
        float gs[8];
#pragma unroll
        for (int sp = 0; sp < 4; ++sp) { gs[2 * sp] = __shfl(gl[0], lb + sp); gs[2 * sp + 1] = __shfl(gl[1], lb + sp); }
        unsigned mask = 0u;
#pragma unroll
        for (int s4 = 0; s4 < 4; ++s4) { float best = -INFINITY; int bi = 0;
#pragma unroll
            for (int gi = 0; gi < 8; ++gi) { const bool ok = !((mask >> gi) & 1u) && (gs[gi] > best); best = ok ? gs[gi] : best; bi = ok ? gi : bi; }
            mask |= 1u << bi; }
        float bv[8]; int be[8];
#pragma unroll
        for (int q = 0; q < 8; ++q) { bv[q] = -INFINITY; be[q] = 0x7fffffff; }
#define TOPK_INSERT(v_, e_) do { float v = (v_); int e = (e_); _Pragma("unroll") for (int q = 0; q < 8; ++q) { const bool gt = (v > bv[q]) || (v == bv[q] && e < be[q]); \
            const float tv = bv[q]; const int te = be[q]; bv[q] = gt ? v : tv; be[q] = gt ? e : te; v = gt ? tv : v; e = gt ? te : e; } } while (0)
        {
            int gsel = 0, left = prt;
#pragma unroll
            for (int gi = 0; gi < 8; ++gi) { const bool on = (mask >> gi) & 1u; gsel = (on && left == 0) ? gi : gsel; left -= on ? 1 : 0; }
            for (int j = 0; j < 32; ++j) { const int e0 = gsel * 32 + j; TOPK_INSERT(row[(e0 + r) & 255], e0); } }
#define TOPK_GT(av, ae, bv_, be_) (((av) > (bv_)) || ((av) == (bv_) && (ae) < (be_)))
#define TOPK_CX(i, j) do { const bool sw = TOPK_GT(bv[j], be[j], bv[i], be[i]); const float tv = bv[i]; const int te = be[i]; bv[i] = sw ? bv[j] : tv; be[i] = sw ? be[j] : te; bv[j] = sw ? tv : bv[j]; be[j] = sw ? te : be[j]; } while (0)
#pragma unroll
        for (int st = 1; st <= 2; st <<= 1) { float ov[8]; int oe[8];
#pragma unroll
            for (int q = 0; q < 8; ++q) { ov[q] = __shfl_xor(bv[7 - q], st); oe[q] = __shfl_xor(be[7 - q], st); }
#pragma unroll
            for (int q = 0; q < 8; ++q) { const bool sw = TOPK_GT(ov[q], oe[q], bv[q], be[q]); bv[q] = sw ? ov[q] : bv[q]; be[q] = sw ? oe[q] : be[q]; }
            TOPK_CX(0, 4); TOPK_CX(1, 5); TOPK_CX(2, 6); TOPK_CX(3, 7);
            TOPK_CX(0, 2); TOPK_CX(1, 3); TOPK_CX(4, 6); TOPK_CX(5, 7);
            TOPK_CX(0, 1); TOPK_CX(2, 3); TOPK_CX(4, 5); TOPK_CX(6, 7); }
#undef TOPK_CX
#undef TOPK_GT
#undef TOPK_INSERT
        float sc[8], sum = 0.f;
#pragma unroll
        for (int q = 0; q < 8; ++q) { sc[q] = bv[q] - rb[be[q]]; sum += sc[q]; }
        const float inv = 2.5f / sum;
        int* lrank = (int*)(ws + WS_LRANK);
        __syncthreads();
#pragma unroll
        for (int q = 0; q < 8; ++q) if ((q >> 1) == prt) { const int slot = t * 8 + q; eidx[slot] = be[q]; gatev[slot] = sc[q] * inv; lrank[slot] = __hip_atomic_fetch_add(&hist[be[q]], 1, __ATOMIC_RELAXED, __HIP_MEMORY_SCOPE_WORKGROUP); }
    }
    __syncthreads();
    if (F.tid < NEXP) ((int*)(ws + WS_CNTWG))[F.vcu * NEXP + F.tid] = hist[F.tid];
    __syncthreads();
}
__device__ __forceinline__ int expert_prefix(const Frame& F, const Args& a) {
    const unsigned* cnt = (const unsigned*)(a.ws + WS_CTL) + CW_CNT; LAS int* ps = (LAS int*)(F.lds + LDS_PS_OFF);
    __syncthreads();
    if (F.tid < 64) { int v[4], s = 0;
#pragma unroll
        for (int q = 0; q < 4; ++q) { v[q] = (int)((cnt[F.tid * 4 + q] + 255u) & ~255u); s += v[q]; }
        int inc = s;
#pragma unroll
        for (int o = 1; o < 64; o <<= 1) { const int n = __shfl_up(inc, o); if (F.tid >= o) inc += n; }
        int run = inc - s;
#pragma unroll
        for (int q = 0; q < 4; ++q) { ps[F.tid * 4 + q] = run; run += v[q]; }
        if (F.tid == 63) ps[256] = run; }
    __syncthreads();
    return ps[256] >> 8;
}
__device__ __forceinline__ void p11_place(const Frame& F, const Args& a) {
    unsigned char* ws = a.ws; const int* eidx = (const int*)(ws + WS_EIDX); const float* gatev = (const float*)(ws + WS_GATE);
    unsigned* cnt = (unsigned*)(ws + WS_CTL) + CW_CNT; const int* cntwg = (const int*)(ws + WS_CNTWG); const int* lrank = (const int*)(ws + WS_LRANK);
    int* row_tok = (int*)(ws + WS_ROWTOK); int* row_slot = (int*)(ws + WS_ROWSLOT); float* row_gate = (float*)(ws + WS_ROWGATE);
    LAS int* ps = (LAS int*)(F.lds + LDS_PS_OFF); LAS int* off = (LAS int*)(F.lds + LDSCTL_OFF + 2048); LAS int* tot = off + 256;
    __syncthreads();
    if (F.tid < NEXP) { const int e = F.tid; int o = 0, t = 0;
        for (int w0 = 0; w0 < 256; w0 += 32) { int v[32];
#pragma unroll
            for (int k = 0; k < 32; ++k) v[k] = cntwg[(w0 + k) * NEXP + e];
#pragma unroll
            for (int k = 0; k < 32; ++k) { t += v[k]; o += (w0 + k < F.vcu) ? v[k] : 0; } }
        off[e] = o; tot[e] = t; if (F.vcu == 0) cnt[e] = (unsigned)t; }
    __syncthreads();
    if (F.tid < 64) { int v[4], sm = 0;
#pragma unroll
        for (int q = 0; q < 4; ++q) { v[q] = (tot[F.tid * 4 + q] + 255) & ~255; sm += v[q]; }
        int inc = sm;
#pragma unroll
        for (int o = 1; o < 64; o <<= 1) { const int n = __shfl_up(inc, o); if (F.tid >= o) inc += n; }
        int run = inc - sm;
#pragma unroll
        for (int q = 0; q < 4; ++q) { ps[F.tid * 4 + q] = run; run += v[q]; }
        if (F.tid == 63) ps[256] = run; }
    __syncthreads();
    for (int q = F.tid; q < 1024; q += 512) { const int slot = F.vcu * 1024 + q, e = eidx[slot]; const int pos = ps[e] + off[e] + lrank[slot];
        row_tok[pos] = slot >> 3; row_slot[pos] = slot; row_gate[pos] = gatev[slot]; }
    { const int e = F.vcu; const int lo = ps[e] + tot[e], hi = ps[e + 1];
        for (int pos = lo + F.tid; pos < hi; pos += 512) { row_tok[pos] = 0; row_slot[pos] = -1; row_gate[pos] = 0.f; } }
    __syncthreads();
}

__device__ __forceinline__ void p14_load(u32x4 (&ys)[2][9], u32x4 (&xs)[2][2], const unsigned char* YS, const bf16_t* X1, const int t0, const int c0) {
#pragma unroll
    for (int q = 0; q < 2; ++q) { const int t = t0 + q;
#pragma unroll
        for (int k = 0; k < 8; ++k) ys[q][k] = *(const u32x4*)(YS + (size_t)(t * 8 + k) * 1024 + c0);
        ys[q][8] = *(const u32x4*)(YS + (size_t)(TOK * TOPK + t) * 1024 + c0);
#pragma unroll
        for (int j = 0; j < 2; ++j) xs[q][j] = *(const u32x4*)(X1 + (size_t)t * 1024 + c0 + 8 * j); }
}
__device__ __forceinline__ void p14_proc(u32x4 (&ys)[2][9], u32x4 (&xs)[2][2], float* out, const LAS f32x4* cst, const int t0, const int lane) {
    typedef float f2_t __attribute__((ext_vector_type(2)));
    const int c0 = 16 * lane;
#pragma unroll
    for (int q = 0; q < 2; ++q) { const int t = t0 + q; f32x4 v[4], y[4];
#pragma unroll
        for (int j = 0; j < 2; ++j) { unpack8(xs[q][j], v[2 * j], v[2 * j + 1]); y[2 * j] = (f32x4){0.f, 0.f, 0.f, 0.f}; y[2 * j + 1] = (f32x4){0.f, 0.f, 0.f, 0.f}; }
        {   float s1 = 0.f;
#pragma unroll
            for (int j = 0; j < 4; ++j) s1 += (v[j].x + v[j].y) + (v[j].z + v[j].w);
            const float mean1 = wave_sum(s1) * (1.f / 1024.f); float q1 = 0.f;
#pragma unroll
            for (int j = 0; j < 4; ++j) { v[j] = v[j] - mean1; q1 += (v[j].x * v[j].x + v[j].y * v[j].y) + (v[j].z * v[j].z + v[j].w * v[j].w); }
            const float rstd1 = 1.f / sqrtf(wave_sum(q1) * (1.f / 1024.f) + LN_EPS);
#pragma unroll
            for (int j = 0; j < 4; ++j) v[j] = v[j] * rstd1 * cst[(3 * 4 + j) * 64 + lane] + cst[(4 * 4 + j) * 64 + lane]; }
#pragma unroll
        for (int k = 0; k < 9; ++k) {
#pragma unroll
            for (int j = 0; j < 4; ++j) { const int w = (int)ys[q][k][j]; const f2_t lo = __builtin_amdgcn_cvt_pk_f32_fp8(w, false), hi = __builtin_amdgcn_cvt_pk_f32_fp8(w, true);
                y[j] += (f32x4){lo.x, lo.y, hi.x, hi.y}; } }
        float s = 0.f;
#pragma unroll
        for (int j = 0; j < 4; ++j) { v[j] = v[j] * ALPHA + cst[(0 * 4 + j) * 64 + lane] * (y[j] * (1.f / YS_SCALE)); s += (v[j].x + v[j].y) + (v[j].z + v[j].w); }
        const float mean = wave_sum(s) * (1.f / 1024.f); float s2 = 0.f;
#pragma unroll
        for (int j = 0; j < 4; ++j) { v[j] = v[j] - mean; s2 += (v[j].x * v[j].x + v[j].y * v[j].y) + (v[j].z * v[j].z + v[j].w * v[j].w); }
        const float rstd = 1.f / sqrtf(wave_sum(s2) * (1.f / 1024.f) + LN_EPS);
#pragma unroll
        for (int j = 0; j < 4; ++j) *(f32x4*)(out + (size_t)t * 1024 + c0 + 4 * j) = v[j] * rstd * cst[(1 * 4 + j) * 64 + lane] + cst[(2 * 4 + j) * 64 + lane]; }
}
__device__ __forceinline__ void p14_final(const Frame& F, const Args& a) {
    unsigned char* ws = a.ws; const bf16_t* X1 = (const bf16_t*)(ws + WS_R1); const unsigned char* YS = ws + WS_YSLOT; const float* mod = (const float*)(ws + WS_MOD);
    const int b = F.vcu >> 5, c0 = 16 * F.lane, tb = F.vcu * 128 + F.wave * 2;
    u32x4 ya[2][9], xa[2][2], yb[2][9], xb[2][2];
    p14_load(ya, xa, YS, X1, tb, c0); p14_load(yb, xb, YS, X1, tb + 16, c0); CFENCE();
    LAS f32x4* cst = (LAS f32x4*)F.lds;
    __syncthreads();
    if (F.tid < 256) { const int j = F.tid >> 6, l = F.tid & 63, c = 16 * l + 4 * j;
        cst[(0 * 4 + j) * 64 + l] = *(const f32x4*)(mod + b * 6144 + 5120 + c); cst[(1 * 4 + j) * 64 + l] = *(const f32x4*)(a.in[I_LN2G] + c); cst[(2 * 4 + j) * 64 + l] = *(const f32x4*)(a.in[I_LN2B] + c);
        cst[(3 * 4 + j) * 64 + l] = *(const f32x4*)(a.in[I_LN1G] + c); cst[(4 * 4 + j) * 64 + l] = *(const f32x4*)(a.in[I_LN1B] + c); }
    __syncthreads();
    CFENCE();
#pragma unroll 1
    for (int i = 0; i < 3; ++i) { const int t0 = tb + 32 * i;
        p14_proc(ya, xa, a.out, cst, t0, F.lane); CFENCE(); p14_load(ya, xa, YS, X1, t0 + 32, c0); CFENCE();
        p14_proc(yb, xb, a.out, cst, t0 + 16, F.lane); CFENCE(); p14_load(yb, xb, YS, X1, t0 + 48, c0); CFENCE(); }
    p14_proc(ya, xa, a.out, cst, tb + 96, F.lane); CFENCE();
    p14_proc(yb, xb, a.out, cst, tb + 112, F.lane);
}

constexpr int N_PHASES = 15;

__global__ void __launch_bounds__(512, 2) fwd_kernel(Args a) {
    extern __shared__ __attribute__((aligned(16))) unsigned char lds_raw[];
    Frame F; F.lds = (LAS unsigned char*)lds_raw; F.tid = threadIdx.x; F.lane = F.tid & 63; F.wave = __builtin_amdgcn_readfirstlane(F.tid >> 6);
    F.G = gridDim.x; { const int bx = blockIdx.x; F.vcu = (F.G % 8 == 0) ? (bx % 8) * (F.G / 8) + bx / 8 : bx; }
    unsigned char* ws = a.ws;
    unsigned* ctl = (unsigned*)(ws + WS_CTL);
    for (int u = F.tid; u < (LDS_BYTES - LDSCTL_OFF) / 4; u += 512) ((LAS unsigned*)(F.lds + LDSCTL_OFF))[u] = 0u;
    __syncthreads();
    __builtin_amdgcn_s_setreg(1473, 1u);
    const int lo = a.ph_lo, hi = a.ph_hi;
    XcdBarrier bar; bar.bar = ctl + CW_BAR; bar.x = 0; bar.st = nullptr;
    if (hi - lo > 1) bar = xcd_barrier_post(ctl + CW_BAR, (volatile LAS unsigned*)(F.lds + LDSCTL_OFF));
#ifndef PHASE_MASK
#define PHASE_MASK 0x7fff
#endif
#define IN(k) (((PHASE_MASK >> (k)) & 1) && lo <= (k) && (k) < hi)
#define SEAM(k) do { if (IN(k) && IN((k) + 1)) xcd_barrier(bar); } while (0)
    LAS unsigned char* ring = F.lds;
    const int G = F.G, c = F.vcu;

    if (IN(0)) { p0_prologue(F, a, 2); } SEAM(0);
    if (IN(1)) { p1_modulate(F, a); } SEAM(1);
    if (IN(2)) {
        LAS float* lbin = (LAS float*)(F.lds + LDS_TAB_OFF);
        for (int q = F.tid; q < 3072; q += 512) lbin[q] = a.in[I_BIN][q];
        __syncthreads();
        { SchedDense S; S.init(ws + WS_U, 1024, 0, ws + WS_WIN, 1024, 0, 128, 2, 1, 512, G, c); EpiS5U E{(bf16_t*)(ws + WS_UX), lbin}; pg8::gemm_phase<EpiS5U, SchedDense, PG_ALIGN, PG_SP2, true>(ring, S, E); }
        { SchedDense S; S.init(ws + WS_WIN + (size_t)512 * 1024, 1024, 0, ws + WS_U, 1024, 0, 2, 128, 1, 512, G, c); EpiFT E{(bf16_t*)(ws + WS_UFT), lbin + 512}; pg8::gemm_phase<EpiFT, SchedDense, PG_ALIGN, PG_SP2, true>(ring, S, E); }
        { SchedDense S; S.init(ws + WS_U, 1024, 0, ws + WS_WIN + (size_t)1024 * 1024, 1024, 0, 128, 8, 1, 512, G, c); EpiGate E{ws + WS_GATES, lbin + 1024}; pg8::gemm_phase<EpiGate, SchedDense, PG_ALIGN, PG_SP2, true>(ring, S, E); }
        p0_prologue(F, a, 28);
    } SEAM(2);
    if (IN(3)) {
        fourier_stage1(F, a);
        __syncthreads();
        { SchedDense S; S.init(ws + WS_UX, 1024, (size_t)2048 * 1024, ws + WS_S5MB, 512, (size_t)256 * 512, 8, 1, NGRP, 256, G, c);
          EpiB16 E{(bf16_t*)(ws + WS_S), 256, (size_t)2048 * 256}; pg8::gemm_phase<EpiB16, SchedDense, PG_ALIGN, PG_SP2>(ring, S, E); }
        VM_WAIT(); __syncthreads();
        s5_scan(F, a);
    } SEAM(3);
    if (IN(4)) {
        { SchedDense S; S.init(ws + WS_UX, 1024, (size_t)2048 * 1024, ws + WS_S5TC, 1024, (size_t)256 * 1024, 8, 1, NGRP, 512, G, c);
          EpiS5Y E{ws + WS_Z}; pg8::gemm_phase<EpiS5Y, SchedDense, PG_ALIGN, PG_SP2>(ring, S, E); }
        { SchedDft2 S; S.init(ws + WS_DFT, 1024, (size_t)512 * 1024, ws + WS_YT, 1024, (size_t)512 * 1024, 2, 2, NB * 16, 512, G, c);
          EpiZc2 E{ws + WS_ZC}; pg8::gemm_phase<EpiZc2, SchedDft2, PG_ALIGN, PG_SP2>(ring, S, E); }
    }
    if (IN(5)) { } SEAM(5);
    if (IN(6)) {
        LAS float* lb6 = (LAS float*)(F.lds + LDS_TAB_OFF);
        for (int q = F.tid; q < 3072; q += 512) lb6[q] = q < 2048 ? a.in[I_BGLU][q] : a.in[I_BF][q - 2048];
        __syncthreads();
        { SchedPanel S; S.init(ws + WS_Z, 512, 0, ws + WS_WGLU, 512, 0, 128, 8, 1, 256, G, c); S.npc = 4; EpiGlu E{ws + WS_P, lb6}; pg8::gemm_phase<EpiGlu, SchedPanel, PG_ALIGN, PG_SP2, true>(ring, S, E); }
        VM_WAIT(); __syncthreads();
        { SchedPanel S; S.init(ws + WS_ZC, 1024, 0, ws + WS_WFP, 1024, 0, 128, 4, 1, 512, G, c); S.npc = 2; EpiMerge E{ws + WS_MERGED, ws + WS_P, ws + WS_GATES, lb6 + 2048}; pg8::gemm_phase<EpiMerge, SchedPanel, PG_ALIGN, PG_SP2, true>(ring, S, E); }
    } SEAM(6);
    if (IN(7)) {
        SchedDense S; S.init(ws + WS_MERGED, 1024, 0, ws + WS_WOUT, 1024, 0, 128, 4, 1, 512, G, c);
        EpiOut E{(bf16_t*)(ws + WS_R1), a.in[I_X], (const float*)(ws + WS_MOD), a.in[I_BOUT]}; pg8::gemm_phase<EpiOut, SchedDense, PG_ALIGN, PG_SP2, true>(ring, S, E);
    } SEAM(7);
    if (IN(8)) { p8_ln1(F, a); } SEAM(8);
    if (IN(9)) {
        unsigned* pflag = ctl + CW_PAIR + 16 * (c >> 1);
        if ((c & 1) == 0) { { SchedDense S; S.init(ws + WS_H, 2048, 0, ws + WS_WRT, 2048, 0, 128, 1, 1, 1024, G / 2, c >> 1); EpiF32 E{(float*)(ws + WS_LOGITS), 256, 0}; pg8::gemm_phase<EpiF32, SchedDense, PG_ALIGN, PG_SP2>(ring, S, E); }
            VM_WAIT(); __syncthreads();
            if (F.tid == 0) { __builtin_amdgcn_fence(__ATOMIC_RELEASE, "agent"); asm volatile("s_waitcnt vmcnt(0)" ::: "memory"); __hip_atomic_store(pflag, 1u, __ATOMIC_RELAXED, __HIP_MEMORY_SCOPE_AGENT); }
        } else { { SchedDense S; S.init(ws + WS_H8, 1024, 0, ws + WS_WSHGU, 1024, 0, 128, 2, 1, 512, G / 2, c >> 1); EpiSwi8 E{ws + WS_HID, SH_TILE0 * 256, 1.f / (W_SCALE * H_SCALE)}; pg8::gemm_phase<EpiSwi8, SchedDense, PG_ALIGN, PG_SP2, true>(ring, S, E); }
            if (F.tid == 0) { XB_SPIN(xb_ld(pflag) == 0u, ctl + CW_BAR); __builtin_amdgcn_fence(__ATOMIC_ACQUIRE, "agent"); }
            __syncthreads();
        }
        p10_route(F, a);
    }
    if (IN(10)) { } SEAM(10);
    if (IN(11)) { p11_place(F, a); } SEAM(11);
    if (IN(12)) {
        const int ntiles = expert_prefix(F, a);
        LAS int* ttok = (LAS int*)(F.lds + LDS_TAB_OFF);
        { const int* row_tok = (const int*)(ws + WS_ROWTOK); const int per = (ntiles * 2 + G - 1) / G;
          int tk[5];
#pragma unroll
          for (int k = 0; k < 5; ++k) { const int q = F.tid + 512 * k, mt = ((q >> 8) * G + c) >> 1; const bool ok = q < per * 256 && mt < ntiles; const int v = row_tok[ok ? mt * 256 + (q & 255) : 0]; tk[k] = ok ? v : 0; }
#pragma unroll
          for (int k = 0; k < 5; ++k) { const int q = F.tid + 512 * k; if (q < per * 256) ttok[q] = tk[k]; }
          __syncthreads(); }
        SchedExp<2, true> S; S.A = (const char*)(ws + WS_H8); S.B = (const char*)(ws + WS_EGU); S.row_tok = ttok; S.ps = (const LAS int*)(F.lds + LDS_PS_OFF); S.uexp = (const LAS int*)(F.lds + LDS_UEXP_OFF);
        S.lda = 1024; S.ldb = 1024; S.eB = (size_t)512 * 1024; S.tB = (size_t)256 * 1024; S.ntiles = ntiles; S.nsh = 0; S.nt = 8; S.G = G; S.c = c; S.kstepA = 128; S.kstepB = 128; S.hstepA = 0; S.hstepB = (size_t)128 * 1024;
        S.fill_unit_experts((LAS int*)(F.lds + LDS_UEXP_OFF));
        EpiSwi8 E{ws + WS_HID, 0, 1.f / (W_SCALE * H_SCALE)}; pg8::gemm_phase<EpiSwi8, SchedExp<2, true>, PG_ALIGN, PG_SP2, true>(ring, S, E);
    } SEAM(12);
    if (IN(13)) {
        const int ntiles = expert_prefix(F, a);
        LAS unsigned* tab = (LAS unsigned*)(F.lds + LDS_TAB_OFF);
        { const int* row_slot = (const int*)(ws + WS_ROWSLOT); const float* row_gate = (const float*)(ws + WS_ROWGATE); const int per = ((ntiles + TOK / 256) * 4 + G - 1) / G;
          int sl[11]; float gv[11];
#pragma unroll
          for (int k = 0; k < 11; ++k) { const int q = F.tid + 512 * k, tl = ((q >> 8) * G + c) >> 2; const int r = (q < per * 256 && tl < ntiles) ? tl * 256 + (q & 255) : 0; sl[k] = row_slot[r]; gv[k] = row_gate[r]; }
#pragma unroll
          for (int k = 0; k < 11; ++k) { const int q = F.tid + 512 * k, tl = ((q >> 8) * G + c) >> 2; unsigned w = (unsigned)(TOK * TOPK + TOK + c);
              if (tl < ntiles) { if (sl[k] >= 0) w = (unsigned)sl[k] | ((unsigned)(gv[k] * 3000.f + 0.5f) << 19); }
              else if (tl < ntiles + TOK / 256) w = (unsigned)(TOK * TOPK + (tl - ntiles) * 256 + (q & 255)) | (3000u << 19);
              if (a.flags & 1) w = (unsigned)(TOK * TOPK + TOK + 256 + c * 256 + (q & 255)) | (3000u << 19);
              if (q < per * 256) tab[q] = w; }
          __syncthreads(); }
        SchedExp<4, false, true> S; S.A = (const char*)(ws + WS_HID); S.B = (const char*)(ws + WS_EDN); S.row_tok = nullptr; S.ps = (const LAS int*)(F.lds + LDS_PS_OFF); S.uexp = (const LAS int*)(F.lds + LDS_UEXP_OFF);
        S.lda = 256; S.ldb = 256; S.eB = (size_t)1024 * 256; S.tB = (size_t)256 * 256; S.ntiles = ntiles; S.nsh = TOK / 256; S.dbg = a.flags; S.nt = 2; S.G = G; S.c = c; S.kstepA = 128; S.kstepB = 128; S.hstepA = (size_t)128 * 256; S.hstepB = (size_t)128 * 256;
        S.fill_unit_experts((LAS int*)(F.lds + LDS_UEXP_OFF));
        EpiExDn E{ws + WS_YSLOT, tab, a.flags}; pg8::gemm_phase<EpiExDn, SchedExp<4, false, true>, PG_ALIGN, PG_SP2, true, P13_NT2 ? 8 : -1>(ring, S, E);
    } SEAM(13);
    if (IN(14)) { p14_final(F, a);
    }
#undef IN
#undef SEAM
}


extern "C" void kernel_launch(void* const* d_in, const int* in_sizes, int n_in, void* d_out, int out_size, void* d_ws, size_t ws_size, hipStream_t stream) {
    static int grid = 0;
    if (grid == 0) {
        if (n_in != 32 || in_sizes[0] != TOK * DM || out_size != TOK * DM || ws_size < WS_END) {
            fprintf(stderr, "kernel_launch: unexpected shapes (n_in %d, in0 %d, out %d, ws %zu, need %zu); nothing launched\n", n_in, n_in > 0 ? in_sizes[0] : -1, out_size, ws_size, (size_t)WS_END); grid = -1; return; }
        int dev = 0, cus = 0, per_cu = 0;
        if (hipGetDevice(&dev) != hipSuccess || hipDeviceGetAttribute(&cus, hipDeviceAttributeMultiprocessorCount, dev) != hipSuccess) { grid = -1; return; }
        if (hipFuncSetAttribute((const void*)fwd_kernel, hipFuncAttributeMaxDynamicSharedMemorySize, LDS_BYTES) != hipSuccess) { fprintf(stderr, "kernel_launch: hipFuncSetAttribute failed\n"); grid = -1; return; }
        if (hipOccupancyMaxActiveBlocksPerMultiprocessor(&per_cu, (const void*)fwd_kernel, 512, LDS_BYTES) != hipSuccess || per_cu < 1) { fprintf(stderr, "kernel_launch: occupancy query reports %d blocks per CU\n", per_cu); (void)hipGetLastError(); grid = -1; return; }
        grid = cus;
        if (grid != 256) { fprintf(stderr, "kernel_launch: built for a 256-CU device, found %d CUs\n", cus); grid = -1; return; }
    }
    if (grid < 0) return;
    if (hipMemsetAsync((char*)d_ws + WS_CTL, 0, CTL_ZERO_BYTES, stream) != hipSuccess) return;
    Args a{};
    for (int i = 0; i < 32; ++i) a.in[i] = (const float*)d_in[i];
    a.out = (float*)d_out; a.ws = (unsigned char*)d_ws;
#if MK_N_LAUNCHES == 1
    a.ph_lo = 0; a.ph_hi = N_PHASES;
    hipLaunchKernelGGL(fwd_kernel, dim3(grid), dim3(512), LDS_BYTES, stream, a);
#ifdef DBG_EXTRA_PHASE
    a.ph_lo = DBG_EXTRA_PHASE; a.ph_hi = DBG_EXTRA_PHASE + 1; a.flags = DBG_EXTRA_FLAGS;
    hipLaunchKernelGGL(fwd_kernel, dim3(grid), dim3(512), LDS_BYTES, stream, a);
#endif
#else
    for (int p = 0; p < N_PHASES; ++p) { a.ph_lo = p; a.ph_hi = p + 1; hipLaunchKernelGGL(fwd_kernel, dim3(grid), dim3(512), LDS_BYTES, stream, a); }
#endif
}
```

```cpp
#include <hip/hip_runtime.h>
#include <cstdio>
#include <cstdint>

#ifndef PG_SP2
#define PG_SP2 true
#define PG_ALIGN true
#endif
#ifndef P13_NT2
#define P13_NT2 0
#endif
#ifndef MK_N_LAUNCHES
#define MK_N_LAUNCHES 1
#endif

#define LAS __attribute__((address_space(3)))
#define GAS __attribute__((address_space(1)))
typedef unsigned short bf16_t;
typedef short bf16x8 __attribute__((ext_vector_type(8)));
typedef float f32x4 __attribute__((ext_vector_type(4)));
typedef unsigned u32x4 __attribute__((ext_vector_type(4)));
typedef unsigned u32x2 __attribute__((ext_vector_type(2)));

constexpr int NB = 8, SEQ = 4096, DM = 1024, TOK = NB * SEQ;
constexpr int NEXP = 256, TOPK = 8, DEXP = 256;
constexpr int NGRP = 32;
constexpr float ALPHA = 1.189207115002721f;
constexpr float LN_EPS = 1e-5f;
constexpr int MAXROWS = TOK * TOPK + NEXP * 256;
constexpr int SH_TILE0 = MAXROWS / 256;

constexpr size_t MiB = 1u << 20;
constexpr size_t WS_CTL = 0, CTL_ZERO_BYTES = 64 * 1024;
constexpr size_t WS_MODP = 1 * MiB;
constexpr size_t WS_MOD = WS_MODP + 1536 * 1024;
constexpr size_t WS_EIDX = 3 * MiB, WS_GATE = 4 * MiB;
constexpr size_t WS_ROWTOK = 5 * MiB, WS_ROWSLOT = WS_ROWTOK + 1280 * 1024, WS_ROWGATE = WS_ROWSLOT + 1280 * 1024;
constexpr size_t WS_WIN = 9 * MiB, WS_WGLU = 15 * MiB, WS_WFP = 17 * MiB, WS_WOUT = 19 * MiB, WS_WRT = 21 * MiB, WS_WSHGU = WS_WRT + 512 * 1024, WS_WSHDN = WS_WSHGU + 1 * MiB;
constexpr size_t WS_S5MB = 23 * MiB, WS_S5TC = 27 * MiB;
constexpr size_t WS_EDN = 36 * MiB, WS_EGU = 164 * MiB, WS_ACT = 420 * MiB;
constexpr size_t WS_U = 420 * MiB, WS_UX = 484 * MiB, WS_UFT = 548 * MiB, WS_GATES = 580 * MiB, WS_S = 708 * MiB, WS_DFT = 772 * MiB;
constexpr size_t WS_ZC = 836 * MiB, WS_Z = 900 * MiB, WS_P = 420 * MiB, WS_MERGED = 932 * MiB, WS_R1 = 580 * MiB  , WS_X1 = 836 * MiB;
constexpr size_t WS_U8 = 836 * MiB;
constexpr size_t WS_YT = 932 * MiB;
constexpr size_t WS_H8 = 544 * MiB;
constexpr size_t WS_SHARED = 420 * MiB;
constexpr size_t WS_LRANK = 540 * MiB, WS_CNTWG = 541 * MiB;
constexpr size_t WS_H = 420 * MiB, WS_LOGITS = 484 * MiB, WS_HIDSH = 516 * MiB, WS_HID = 676 * MiB, WS_YSLOT = 164 * MiB, WS_END = 1024 * MiB;
static_assert(WS_HID + (size_t)(MAXROWS + TOK) * 256 <= WS_X1 && WS_YSLOT + (size_t)TOK * TOPK * 2048 <= WS_HID && WS_X1 + (size_t)TOK * DM * 4 <= WS_END, "ws map");
constexpr int CW_BAR = 4096, CW_CNT = 8192, CW_CUR = 8448, CW_PAIR = 12288  , CW_ADA = 15360  , CW_YT = 15424  , CW_P2 = 15488  ;

constexpr int RING_BYTES = 131072, LDSCTL_OFF = RING_BYTES, LDS_PS_OFF = LDSCTL_OFF + 256  , LDS_UEXP_OFF = LDSCTL_OFF + 1536  , LDS_TAB_OFF = LDSCTL_OFF + 2048  , LDS_BYTES = 163840;

typedef __bf16 bf16x2_t __attribute__((ext_vector_type(2)));
typedef float f32x2_t __attribute__((ext_vector_type(2)));
__device__ __forceinline__ unsigned cvt_pk_bf16(float lo, float hi) { const f32x2_t f = {lo, hi}; const bf16x2_t v = __builtin_convertvector(f, bf16x2_t); return __builtin_bit_cast(unsigned, v); }
constexpr float YS_SCALE = 64.f, W_SCALE = 64.f, H_SCALE = 8.f, HID_SCALE = 8.f, U_SCALE = 8.f;
constexpr float INPROJ_DESCALE = 1.f / (W_SCALE * U_SCALE);
constexpr float Z_SCALE = 8.f, ZC_SCALE = 0.0625f, WFP_SCALE = 2048.f;
constexpr float MG_SCALE = 8.f;
__device__ __forceinline__ float sat8(float v) { return __builtin_amdgcn_fmed3f(v, -448.f, 448.f); }
__device__ __forceinline__ unsigned pk4_fp8(const f32x4 v, float sc) { const f32x4 t = v * sc; int w = 0; w = __builtin_amdgcn_cvt_pk_fp8_f32(t.x, t.y, w, false); w = __builtin_amdgcn_cvt_pk_fp8_f32(t.z, t.w, w, true); return (unsigned)w; }
__device__ __forceinline__ f32x4 unpk4_fp8(unsigned w) { typedef float f2_t __attribute__((ext_vector_type(2))); const f2_t lo = __builtin_amdgcn_cvt_pk_f32_fp8((int)w, false), hi = __builtin_amdgcn_cvt_pk_f32_fp8((int)w, true); return (f32x4){lo.x, lo.y, hi.x, hi.y}; }
constexpr float P_SCALE = 8.f;
constexpr float GATE_SCALE = 256.f;
__device__ __forceinline__ float bf_lo(unsigned u) { return __builtin_bit_cast(float, u << 16); }
__device__ __forceinline__ float bf_hi(unsigned u) { return __builtin_bit_cast(float, u & 0xffff0000u); }
__device__ __forceinline__ void fast_sincos(float rad, float& sn, float& cs) { const float rev = __builtin_amdgcn_fractf(rad * 0.15915494309189535f); sn = __builtin_amdgcn_sinf(rev); cs = __builtin_amdgcn_cosf(rev); }
__device__ __forceinline__ float sigm(float x) { return __builtin_amdgcn_rcpf(1.f + __expf(-x)); }
__device__ __forceinline__ float gelu_tanh(float x) { return x * sigm(1.5957691216057308f * (x + 0.044715f * x * x * x)); }
template <int CTRL> __device__ __forceinline__ float dpp_f(float v) { return __builtin_bit_cast(float, __builtin_amdgcn_update_dpp(0, __builtin_bit_cast(int, v), CTRL, 0xf, 0xf, true)); }
template <int CTRL> __device__ __forceinline__ int dpp_i(int v) { return __builtin_amdgcn_update_dpp(0, v, CTRL, 0xf, 0xf, true); }
__device__ __forceinline__ float wave_sum(float v) {
    v += dpp_f<0xB1>(v); v += dpp_f<0x4E>(v); v += dpp_f<0x141>(v); v += dpp_f<0x140>(v);
#if defined(__HIP_DEVICE_COMPILE__)
    { auto r = __builtin_amdgcn_permlane16_swap(__float_as_uint(v), __float_as_uint(v), false, false); v = __uint_as_float(r[0]) + __uint_as_float(r[1]); }
    { auto r = __builtin_amdgcn_permlane32_swap(__float_as_uint(v), __float_as_uint(v), false, false); v = __uint_as_float(r[0]) + __uint_as_float(r[1]); }
#endif
    return v;
}
#define CFENCE() asm volatile("" ::: "memory")
__device__ __forceinline__ void st16_wt(void* p, const f32x4 v) {
#if defined(__HIP_DEVICE_COMPILE__)
    asm volatile("global_store_dwordx4 %0, %1, off sc1\n\ts_nop 1" :: "v"(p), "v"(v) : "memory");
#else
    (void)p; (void)v;
#endif
}
#define LDS_WAIT() asm volatile("s_waitcnt lgkmcnt(0)" ::: "memory")
#define VM_WAIT() asm volatile("s_waitcnt vmcnt(0)" ::: "memory")

#define XB_TMO      128
#define XB_XCNT(j)  (256  + 64 * (j))
#define XB_XSUB(j)  (1280 + 64 * (j))
#define XB_XGEN(j)  (2304 + 64 * (j))
#define XB_TOP      3328
#define XB_TOPGEN   3392
#define XCD_BAR_WORDS 3456
#define XB_SPIN_CAP (1u << 18)
__device__ __forceinline__ unsigned xb_ld(unsigned* p)              { return __hip_atomic_load(p, __ATOMIC_RELAXED, __HIP_MEMORY_SCOPE_AGENT); }
__device__ __forceinline__ unsigned xb_add(unsigned* p, unsigned v) { return __hip_atomic_fetch_add(p, v, __ATOMIC_RELAXED, __HIP_MEMORY_SCOPE_AGENT); }
__device__ __forceinline__ unsigned xb_xcc_id() { return (unsigned)__builtin_amdgcn_s_getreg((3 << 11) | 20) & 0xFu; }
#define XB_SPIN(cond, bar) do { unsigned _sp = 0; while (cond) { __builtin_amdgcn_s_sleep(1); \
    if ((++_sp & 255u) == 0u) { if (xb_ld(&(bar)[XB_TMO])) break; if (_sp > XB_SPIN_CAP) { atomicAdd(&(bar)[XB_TMO], 1u); break; } } } } while (0)
struct XcdBarrier { unsigned* bar; unsigned x; volatile LAS unsigned* st; };
__device__ __forceinline__ XcdBarrier xcd_barrier_post(unsigned* bar, volatile LAS unsigned* st) {
    XcdBarrier b; b.bar = bar; b.x = xb_xcc_id(); b.st = st;
    if (threadIdx.x == 0) (void)xb_add(&bar[XB_XCNT(b.x)], 1u);
    return b;
}
__device__ __forceinline__ void xcd_barrier_complete(unsigned* bar, unsigned x, unsigned& nloc, unsigned& nx) {
    const unsigned G = gridDim.x * gridDim.y * gridDim.z;
    unsigned sum, cnt, mine, sp = 0u;
    for (;;) {
        sum = 0u; cnt = 0u; mine = 0u;
#pragma unroll
        for (unsigned j = 0; j < 16; ++j) { const unsigned c = xb_ld(&bar[XB_XCNT(j)]); sum += c; cnt += (c > 0u) ? 1u : 0u; mine = (j == x) ? c : mine; }
        if (sum == G) break;
        __builtin_amdgcn_s_sleep(1);
        if ((++sp & 255u) == 0u) { if (xb_ld(&bar[XB_TMO])) break; if (sp > XB_SPIN_CAP) { atomicAdd(&bar[XB_TMO], 1u); break; } }
    }
    nloc = mine > 0u ? mine : 1u; nx = cnt > 0u ? cnt : 1u;
}
__device__ __forceinline__ void xcd_barrier(const XcdBarrier& b) {
    asm volatile("s_waitcnt vmcnt(0)" ::: "memory");
    __syncthreads();
    if (threadIdx.x == 0) {
        unsigned* bar = b.bar;
        __builtin_amdgcn_s_waitcnt(0);
        unsigned nloc = b.st[0], nx = b.st[1];
        if (nloc == 0u) { xcd_barrier_complete(bar, b.x, nloc, nx); b.st[0] = nloc; b.st[1] = nx; }
        const unsigned old = xb_add(&bar[XB_XSUB(b.x)], 1u);
        const unsigned gen = old / nloc;
        if (old + 1u == (gen + 1u) * nloc) {
            __builtin_amdgcn_fence(__ATOMIC_RELEASE, "agent");
            asm volatile("s_waitcnt vmcnt(0)" ::: "memory");
            const unsigned og = xb_add(&bar[XB_TOP], 1u);
            const unsigned tg = og / nx;
            if (og + 1u == (tg + 1u) * nx) xb_add(&bar[XB_TOPGEN], 1u);
            else XB_SPIN(xb_ld(&bar[XB_TOPGEN]) == tg, bar);
            __builtin_amdgcn_fence(__ATOMIC_ACQUIRE, "agent");
            xb_add(&bar[XB_XGEN(b.x)], 1u);
            asm volatile("s_waitcnt vmcnt(0)" ::: "memory");
        } else {
            XB_SPIN(xb_ld(&bar[XB_XGEN(b.x)]) == gen, bar);
            __builtin_amdgcn_fence(__ATOMIC_ACQUIRE, "agent");
            asm volatile("s_waitcnt vmcnt(0)" ::: "memory");
        }
    }
    __syncthreads();
}

namespace pg8 {
constexpr int BM = 256, BK = 64, HALF = 128, HTB = HALF * BK * 2, STAGE_BYTES = 8 * HTB;
__host__ __device__ __forceinline__ int lds_byte(int r, int c) { const int st = (r >> 4) * 2 + (c >> 5), rr = r & 15, cc = c & 31, ob = rr * 64 + cc * 2; return st * 1024 + (ob ^ (((ob >> 9) & 1) << 5)); }
__host__ __device__ __forceinline__ void stage_rc(int b, int& R, int& C) { const int st = b / 1024, sb = b % 1024, swz = sb ^ (((sb >> 9) & 1) << 5); R = (st >> 1) * 16 + swz / 64; C = (st & 1) * 32 + (swz % 64) / 2; }
__host__ __device__ __forceinline__ int perm32(int rho) { const int n = rho >> 4, i = rho & 15; return 8 * (i >> 2) + 4 * n + (i & 3); }
struct Unit { int pm, pn, z, li; };
typedef int i32x4_t __attribute__((ext_vector_type(4)));
typedef int i32x8_t __attribute__((ext_vector_type(8)));
struct FragT { bf16x8 lo, hi; };
template <bool F8> struct FragSel { typedef FragT type; };
template <> struct FragSel<true> { typedef i32x8_t type; };
__device__ __forceinline__ void frag_load(FragT& d, const LAS unsigned char* p0, const LAS unsigned char* p1) { d.lo = *(const LAS bf16x8*)p0; d.hi = *(const LAS bf16x8*)p1; }
__device__ __forceinline__ void frag_load(i32x8_t& d, const LAS unsigned char* p0, const LAS unsigned char* p1) { const i32x4_t lo = *(const LAS i32x4_t*)p0, hi = *(const LAS i32x4_t*)p1; d = __builtin_shufflevector(lo, hi, 0, 1, 2, 3, 4, 5, 6, 7); }
typedef float f32x4_acc __attribute__((ext_vector_type(4)));
__device__ __forceinline__ void frag_mma(f32x4_acc& c, const FragT& b, const FragT& a) { c = __builtin_amdgcn_mfma_f32_16x16x32_bf16(b.lo, a.lo, c, 0, 0, 0); c = __builtin_amdgcn_mfma_f32_16x16x32_bf16(b.hi, a.hi, c, 0, 0, 0); }
__device__ __forceinline__ void frag_mma(f32x4_acc& c, const i32x8_t& b, const i32x8_t& a) {
#if defined(__HIP_DEVICE_COMPILE__)
    const int sc = 0x7f7f7f7f;
    asm volatile("v_mfma_scale_f32_16x16x128_f8f6f4 %0, %1, %2, %0, %3, %3 op_sel_hi:[0,0,0]" : "+v"(c) : "v"(b), "v"(a), "v"(sc));
#else
    (void)c; (void)b; (void)a;
#endif
}

template <class Epi, class Sched, bool ALIGN_EPI, bool SP2, bool F8 = false, int NST = -1>
__device__ __forceinline__ void gemm_phase(LAS unsigned char* lds, const Sched& S, const Epi& E) {
    const int tid = threadIdx.x, wid = __builtin_amdgcn_readfirstlane(tid >> 6), lane = tid & 63, wr = wid >> 2, wc = wid & 3, fr = lane & 15, fq = lane >> 4;
    const int nt = S.nt;
    int sR[2], sC[2];
    unsigned voffA[2] = {0u, 0u}, vB[2][2];
#pragma unroll
    for (int i = 0; i < 2; ++i) { stage_rc(tid * 16 + i * 8192, sR[i], sC[i]); const int Rb = (sR[i] & ~31) + perm32(sR[i] & 31);
#pragma unroll
        for (int h = 0; h < 2; ++h) { if constexpr (Sched::BMAP) vB[h][i] = S.b_row_off(S.b_map(128 * h + sR[i])) + (unsigned)sC[i] * 2u;
                                      else vB[h][i] = S.b_row_off(Rb) + (unsigned)(h * S.hstepB) + (unsigned)sC[i] * 2u; }
        if constexpr (!Sched::GATHER) voffA[i] = S.a_row_off(sR[i]) + (unsigned)sC[i] * 2u; }
    unsigned vAc[2][2] = {{0u, 0u}, {0u, 0u}}, vAn[2][2] = {{0u, 0u}, {0u, 0u}};
    const size_t kstepA = S.kstepA, kstepB = S.kstepB, hstepA = S.hstepA;
    const unsigned ldsw = (unsigned)wid * 1024u;
    const int f8a = 16 * fq + 8 * (fq & 1), f8b = 16 * fq + 8 * ((fq & 1) ^ 1);
    const int aoff0 = F8 ? lds_byte(wr * 64 + fr, f8a) : lds_byte(wr * 64 + fr, fq * 8), aoff1 = F8 ? lds_byte(wr * 64 + fr, f8b) : aoff0 + 1024;
    const int boff0 = F8 ? lds_byte(wc * 32 + fr, f8a) : lds_byte(wc * 32 + fr, fq * 8), boff1 = F8 ? lds_byte(wc * 32 + fr, f8b) : boff0 + 1024;
#define PG8_SA(b, h) (((b) * 2 + (h)) * HTB)
#define PG8_SB(b, h) ((4 + (b) * 2 + (h)) * HTB)
#define PG8_STAGE(bufoff, gbase, voff) do { _Pragma("unroll") for (int _i = 0; _i < 2; ++_i) \
        __builtin_amdgcn_global_load_lds((const unsigned*)((const char*)(gbase) + (voff)[_i]), (LAS unsigned*)(lds + (bufoff) + ldsw + _i * 8192), 16, 0, 0); } while (0)
#define PG8_STA_CUR(bufoff, kb, h) do { if constexpr (Sched::GATHER) { PG8_STAGE(bufoff, kb, vAc[h]); } else { PG8_STAGE(bufoff, (kb) + (h) * hstepA, voffA); } } while (0)
#define PG8_STA_NX(bufoff, kb, h) do { if constexpr (Sched::GATHER) { const unsigned _v[2] = {last ? vAn[h][0] : vAc[h][0], last ? vAn[h][1] : vAc[h][1]}; PG8_STAGE(bufoff, kb, _v); } else { PG8_STAGE(bufoff, (kb) + (h) * hstepA, voffA); } } while (0)
#define PG8_STB(bufoff, kb, h) PG8_STAGE(bufoff, kb, vB[h])
#define PG8_LDA(dst, b, h) do { _Pragma("unroll") for (int m = 0; m < 4; ++m) frag_load(dst[m], lds + PG8_SA(b, h) + aoff0 + m * 2048, lds + PG8_SA(b, h) + aoff1 + m * 2048); } while (0)
#define PG8_LDB(dst, b, h) do { _Pragma("unroll") for (int n = 0; n < 2; ++n) frag_load(dst[n], lds + PG8_SB(b, h) + boff0 + n * 2048, lds + PG8_SB(b, h) + boff1 + n * 2048); } while (0)
#define PG8_MMA(ai, bj, At, Bt) do { __builtin_amdgcn_s_setprio(1); _Pragma("unroll") for (int m = 0; m < 4; ++m) _Pragma("unroll") for (int n = 0; n < 2; ++n) frag_mma(acc[ai][bj][m][n], Bt[n], At[m]); __builtin_amdgcn_s_setprio(0); } while (0)
#define PG8_WAIT_V(n) asm volatile("s_waitcnt vmcnt(" #n ")" ::: "memory")
#define PG8_WAIT_L(n) asm volatile("s_waitcnt lgkmcnt(" #n ")" ::: "memory")
#define PG8_WAIT_VC(n) asm volatile("s_waitcnt vmcnt(%0)" :: "n"(n) : "memory")
#define PG8_BAR __builtin_amdgcn_s_barrier()
#define PG8_SCHED __builtin_amdgcn_sched_barrier(0)
#define PG8_KBODY \
            const bool last = (t == nt - 2); \
            const char* a1 = cA + (size_t)(t + 1) * kstepA; \
            const char* a2 = last ? nA : cA + (size_t)(t + 2) * kstepA; const char* b2 = last ? nB : cB + (size_t)(t + 2) * kstepB; \
            const char* a3 = a2 + kstepA; const char* b3 = b2 + kstepB; \
            if constexpr (SP2) { \
            PG8_LDB(B0, 0, 0); PG8_LDB(B1, 0, 1); PG8_SCHED; PG8_LDA(At, 0, 0); PG8_STA_CUR(PG8_SA(1, 1), a1, 1); \
            PG8_WAIT_V(8); PG8_WAIT_L(0); PG8_BAR; PG8_MMA(0, 0, At, B0); PG8_MMA(0, 1, At, B1); PG8_BAR; PG8_SCHED; \
            PG8_LDA(At, 0, 1); PG8_STB(PG8_SB(0, 0), b2, 0); PG8_STB(PG8_SB(0, 1), b2, 1); PG8_STA_NX(PG8_SA(0, 0), a2, 0); \
            PG8_WAIT_V(8); PG8_WAIT_L(0); PG8_BAR; PG8_MMA(1, 0, At, B0); PG8_MMA(1, 1, At, B1); PG8_BAR; PG8_SCHED; \
            PG8_LDB(B0, 1, 0); PG8_LDB(B1, 1, 1); PG8_SCHED; PG8_LDA(At, 1, 0); PG8_STA_NX(PG8_SA(0, 1), a2, 1); \
            PG8_WAIT_V(8); PG8_WAIT_L(0); PG8_BAR; PG8_MMA(0, 0, At, B0); PG8_MMA(0, 1, At, B1); PG8_BAR; PG8_SCHED; \
            PG8_LDA(At, 1, 1); PG8_STB(PG8_SB(1, 0), b3, 0); PG8_STB(PG8_SB(1, 1), b3, 1); PG8_STA_NX(PG8_SA(1, 0), a3, 0); \
            PG8_WAIT_V(8); PG8_WAIT_L(0); PG8_BAR; PG8_MMA(1, 0, At, B0); PG8_MMA(1, 1, At, B1); PG8_BAR; PG8_SCHED; \
            } else { \
            PG8_LDB(B0, 0, 0); PG8_SCHED; PG8_LDA(At, 0, 0); PG8_STA_CUR(PG8_SA(1, 1), a1, 1); \
            PG8_WAIT_L(8); PG8_BAR; PG8_WAIT_L(0); PG8_MMA(0, 0, At, B0); PG8_BAR; PG8_SCHED; \
            PG8_LDB(B1, 0, 1); PG8_STB(PG8_SB(0, 0), b2, 0); \
            PG8_BAR; PG8_WAIT_L(0); PG8_MMA(0, 1, At, B1); PG8_BAR; \
            PG8_LDA(At, 0, 1); PG8_STA_NX(PG8_SA(0, 0), a2, 0); \
            PG8_BAR; PG8_WAIT_L(0); PG8_MMA(1, 0, At, B0); PG8_BAR; PG8_SCHED; \
            PG8_STB(PG8_SB(0, 1), b2, 1); \
            PG8_WAIT_V(6); PG8_BAR; PG8_MMA(1, 1, At, B1); PG8_BAR; \
            PG8_LDB(B0, 1, 0); PG8_SCHED; PG8_LDA(At, 1, 0); PG8_STA_NX(PG8_SA(0, 1), a2, 1); \
            PG8_WAIT_L(8); PG8_BAR; PG8_WAIT_L(0); PG8_MMA(0, 0, At, B0); PG8_BAR; PG8_SCHED; \
            PG8_LDB(B1, 1, 1); PG8_STB(PG8_SB(1, 0), b3, 0); \
            PG8_BAR; PG8_WAIT_L(0); PG8_MMA(0, 1, At, B1); PG8_BAR; \
            PG8_LDA(At, 1, 1); PG8_STA_NX(PG8_SA(1, 0), a3, 0); \
            PG8_BAR; PG8_WAIT_L(0); PG8_MMA(1, 0, At, B0); PG8_BAR; PG8_SCHED; \
            PG8_STB(PG8_SB(1, 1), b3, 1); \
            PG8_WAIT_V(6); PG8_BAR; PG8_MMA(1, 1, At, B1); PG8_BAR; \
            }
#define PG8_KBODY_NT2 \
            const bool last = true; (void)last; \
            PG8_LDB(B0, 0, 0); PG8_LDB(B1, 0, 1); PG8_SCHED; PG8_LDA(At, 0, 0); \
            PG8_WAIT_VC(8 + NST); PG8_WAIT_L(0); PG8_BAR; PG8_MMA(0, 0, At, B0); PG8_MMA(0, 1, At, B1); PG8_BAR; PG8_SCHED; \
            PG8_LDA(At, 0, 1); PG8_STB(PG8_SB(0, 0), nB, 0); PG8_STB(PG8_SB(0, 1), nB, 1); PG8_STA_NX(PG8_SA(0, 0), nA, 0); \
            PG8_WAIT_VC(8 + NST); PG8_WAIT_L(0); PG8_BAR; PG8_MMA(1, 0, At, B0); PG8_MMA(1, 1, At, B1); PG8_BAR; PG8_SCHED; \
            PG8_LDB(B0, 1, 0); PG8_LDB(B1, 1, 1); PG8_SCHED; PG8_LDA(At, 1, 0); PG8_STA_NX(PG8_SA(0, 1), nA, 1); \
            PG8_WAIT_VC(8 + NST); PG8_WAIT_L(0); PG8_BAR; PG8_MMA(0, 0, At, B0); PG8_MMA(0, 1, At, B1); PG8_BAR; PG8_SCHED; \
            PG8_LDA(At, 1, 1); PG8_STB(PG8_SB(1, 0), nB + kstepB, 0); PG8_STB(PG8_SB(1, 1), nB + kstepB, 1); PG8_STA_NX(PG8_SA(1, 0), nA + kstepA, 0); \
            PG8_WAIT_V(8); PG8_WAIT_L(0); PG8_BAR; PG8_MMA(1, 0, At, B0); PG8_MMA(1, 1, At, B1); PG8_BAR; PG8_SCHED; \
            PG8_STA_NX(PG8_SA(1, 1), nA + kstepA, 1);
    Unit cur, nxt; int ui = 0;
    if (!S.next(0, cur)) return;
    f32x4 acc[2][2][4][2];
#pragma unroll
    for (int a = 0; a < 2; ++a)
#pragma unroll
        for (int b = 0; b < 2; ++b)
#pragma unroll
            for (int m = 0; m < 4; ++m)
#pragma unroll
                for (int n = 0; n < 2; ++n) acc[a][b][m][n] = (f32x4){0.f, 0.f, 0.f, 0.f};
    typename FragSel<F8>::type At[4], B0[2], B1[2];
    const char* cA = S.a_base(cur); const char* cB = S.b_base(cur);
    if constexpr (Sched::GATHER) {
#pragma unroll
        for (int h = 0; h < 2; ++h)
#pragma unroll
            for (int i = 0; i < 2; ++i) vAc[h][i] = S.a_gather_off(cur, h * HALF + sR[i]) + (unsigned)sC[i] * 2u;
    }
    {   const bool last = false; (void)last;
    if constexpr (NST >= 0) {
        PG8_STB(PG8_SB(0, 0), cB, 0); PG8_STB(PG8_SB(0, 1), cB, 1); PG8_STA_CUR(PG8_SA(0, 0), cA, 0); PG8_STA_CUR(PG8_SA(0, 1), cA, 1);
        PG8_STB(PG8_SB(1, 0), cB + kstepB, 0); PG8_STB(PG8_SB(1, 1), cB + kstepB, 1); PG8_STA_CUR(PG8_SA(1, 0), cA + kstepA, 0); PG8_STA_CUR(PG8_SA(1, 1), cA + kstepA, 1);
        PG8_WAIT_V(0); PG8_BAR;
        if (wr == 1) PG8_BAR;
    } else if constexpr (SP2) {
        PG8_STB(PG8_SB(0, 0), cB, 0); PG8_STB(PG8_SB(0, 1), cB, 1); PG8_STA_CUR(PG8_SA(0, 0), cA, 0); PG8_STA_CUR(PG8_SA(0, 1), cA, 1);
        if (wr == 1) PG8_BAR;
        PG8_WAIT_V(2); PG8_BAR;
        PG8_STB(PG8_SB(1, 0), cB + kstepB, 0); PG8_STA_CUR(PG8_SA(1, 0), cA + kstepA, 0); PG8_STB(PG8_SB(1, 1), cB + kstepB, 1);
        PG8_WAIT_V(6); PG8_BAR;
    } else {
        PG8_STB(PG8_SB(0, 0), cB, 0); PG8_STA_CUR(PG8_SA(0, 0), cA, 0); PG8_STB(PG8_SB(0, 1), cB, 1); PG8_STA_CUR(PG8_SA(0, 1), cA, 1);
        if (wr == 1) PG8_BAR;
        PG8_WAIT_V(4); PG8_BAR;
        PG8_STB(PG8_SB(1, 0), cB + kstepB, 0); PG8_STA_CUR(PG8_SA(1, 0), cA + kstepA, 0); PG8_STB(PG8_SB(1, 1), cB + kstepB, 1);
        PG8_WAIT_V(6); PG8_BAR;
    } }
    for (;;) {
        const bool has_next = S.next(ui + 1, nxt);
        const char* nA = has_next ? S.a_base(nxt) : cA; const char* nB = has_next ? S.b_base(nxt) : cB;
        if constexpr (Sched::GATHER) {
#pragma unroll
            for (int h = 0; h < 2; ++h)
#pragma unroll
                for (int i = 0; i < 2; ++i) vAn[h][i] = S.a_gather_off(has_next ? nxt : cur, h * HALF + sR[i]) + (unsigned)sC[i] * 2u;
        }
        if constexpr (NST >= 0) { PG8_KBODY_NT2 } else { for (int t = 0; t < nt; t += 2) { PG8_KBODY } }
        if constexpr (ALIGN_EPI) { if (wr == 0) PG8_BAR; }
        if constexpr (F8) asm volatile("s_nop 15\n\ts_nop 15" ::: "memory");
        { int tz = threadIdx.x; asm volatile("" : "+v"(tz));
          const int ewid = __builtin_amdgcn_readfirstlane(tz >> 6), el = tz & 63; E(acc, cur, ewid >> 2, ewid & 3, el & 15, el >> 4); }
        if (!has_next) break;
#pragma unroll
        for (int a = 0; a < 2; ++a)
#pragma unroll
            for (int b = 0; b < 2; ++b)
#pragma unroll
                for (int m = 0; m < 4; ++m)
#pragma unroll
                    for (int n = 0; n < 2; ++n) acc[a][b][m][n] = (f32x4){0.f, 0.f, 0.f, 0.f};
        cur = nxt; cA = nA; cB = nB; ++ui;
        if constexpr (Sched::GATHER) {
#pragma unroll
            for (int h = 0; h < 2; ++h)
#pragma unroll
                for (int i = 0; i < 2; ++i) vAc[h][i] = vAn[h][i];
        }
        if constexpr (ALIGN_EPI) { if (wr == 1) PG8_BAR; }
    }
    PG8_WAIT_V(0);
    if constexpr (!ALIGN_EPI) { if (wr == 0) PG8_BAR; }
    PG8_BAR;
#undef PG8_SA
#undef PG8_SB
#undef PG8_STAGE
#undef PG8_STA_CUR
#undef PG8_STA_NX
#undef PG8_STB
#undef PG8_LDA
#undef PG8_LDB
#undef PG8_MMA
#undef PG8_WAIT_V
#undef PG8_WAIT_L
#undef PG8_BAR
#undef PG8_SCHED
#undef PG8_KBODY
#undef PG8_KBODY_NT2
#undef PG8_WAIT_VC
}
}
using pg8::Unit;

struct SchedDense {
    static constexpr bool GATHER = false, BMAP = false;
    __device__ __forceinline__ int b_map(int r) const { return r; }
    const char* A; const char* B; unsigned lda, ldb; size_t zA, zB; int nM, nN, nZ, nt, G, c;
    size_t kstepA, kstepB, hstepA, hstepB;
    __device__ __forceinline__ void init(const void* A_, unsigned lda_, size_t zA_, const void* B_, unsigned ldb_, size_t zB_, int nM_, int nN_, int nZ_, int K, int G_, int c_) {
        A = (const char*)A_; B = (const char*)B_; lda = lda_; ldb = ldb_; zA = zA_; zB = zB_; nM = nM_; nN = nN_; nZ = nZ_; nt = K / 64; G = G_; c = c_;
        kstepA = 128; kstepB = 128; hstepA = (size_t)128 * lda; hstepB = (size_t)128 * ldb; }
    __device__ __forceinline__ bool next(int i, Unit& u) const { const int L = i * G + c, per = nM * nN; if (L >= per * nZ) return false; u.z = L / per; const int w = L % per; u.pm = w / nN; u.pn = w % nN; u.li = i; return true; }
    __device__ __forceinline__ const char* a_base(const Unit& u) const { return A + (size_t)u.z * zA + (size_t)u.pm * 256 * lda; }
    __device__ __forceinline__ const char* b_base(const Unit& u) const { return B + (size_t)u.z * zB + (size_t)u.pn * 256 * ldb; }
    __device__ __forceinline__ unsigned a_row_off(int r) const { return (unsigned)r * lda; }
    __device__ __forceinline__ unsigned b_row_off(int r) const { return (unsigned)r * ldb; }
    __device__ __forceinline__ unsigned a_gather_off(const Unit&, int) const { return 0u; }
};
struct SchedPanel : SchedDense {
    int npc;
    __device__ __forceinline__ bool next(int i, Unit& u) const { if (i >= npc) return false; u.z = 0; u.li = i; u.pm = c >> 1; u.pn = (c & 1) * npc + i; return true; }
};
struct SchedInProj : SchedDense {
    __device__ __forceinline__ bool next(int i, Unit& u) const { if (i >= 6) return false; u.li = i;
        if (i == 0) { u.z = 0; u.pm = c >> 1; u.pn = c & 1; } else if (i == 1) { u.z = 1; u.pm = c >> 7; u.pn = c & 127; } else { const int L = (i - 2) * G + c; u.z = 2; u.pm = L >> 3; u.pn = L & 7; }
        return true; }
    __device__ __forceinline__ const char* a_base(const Unit& u) const { return u.z == 1 ? B + (size_t)(512 + 256 * u.pm) * 1024 : A + (size_t)u.pm * 256 * 1024; }
    __device__ __forceinline__ const char* b_base(const Unit& u) const { return u.z == 0 ? B + (size_t)u.pn * 256 * 1024 : u.z == 1 ? A + (size_t)u.pn * 256 * 1024 : B + (size_t)(1024 + 256 * u.pn) * 1024; }
};
template <int NT, bool GATHER_, bool BMAP_ = false> struct SchedExp {
    static constexpr bool GATHER = GATHER_, BMAP = BMAP_;
    __device__ __forceinline__ int b_map(int r) const { return 256 * (2 * (r >> 7) + ((r >> 4) & 1)) + 4 * (4 * ((r >> 5) & 3) + ((r >> 2) & 3)) + (r & 3); }
    const char* A; const char* B; const LAS int* row_tok  ; const LAS int* ps; const LAS int* uexp; unsigned lda, ldb; size_t eB, tB; int ntiles, nsh  , nt, G, c, dbg = 0;
    size_t kstepA, kstepB, hstepA, hstepB;
    __device__ __forceinline__ bool next(int i, Unit& u) const {
        const int L = i * G + c, tl = L / NT; if (tl >= ntiles + nsh) return false;
        u.pm = tl < ntiles ? tl : SH_TILE0 + (tl - ntiles); u.pn = L % NT; u.li = i; u.z = __builtin_amdgcn_readfirstlane(uexp[i]); return true; }
    __device__ __forceinline__ void fill_unit_experts(LAS int* tab) const {
        const int per = ((ntiles + nsh) * NT + G - 1) / G;
        if ((int)threadIdx.x < per) { const int mt = ((int)threadIdx.x * G + c) / NT; const int r0 = mt * 256; int lo = 0, hi = NEXP;
#pragma unroll
            for (int s = 0; s < 8; ++s) { const int mid = (lo + hi) >> 1; if (ps[mid] <= r0) lo = mid; else hi = mid; }
            tab[threadIdx.x] = mt < ntiles ? lo : NEXP; }
        __syncthreads(); }
    __device__ __forceinline__ const char* a_base(const Unit& u) const { return GATHER_ ? A : A + (size_t)((dbg & 2) ? c : u.pm) * 256 * lda; }
    __device__ __forceinline__ const char* b_base(const Unit& u) const { return B + (size_t)((dbg & 2) ? 0 : u.z) * eB + (size_t)u.pn * tB; }
    __device__ __forceinline__ unsigned a_row_off(int r) const { return (unsigned)r * lda; }
    __device__ __forceinline__ unsigned b_row_off(int r) const { return (unsigned)r * ldb; }
    __device__ __forceinline__ unsigned a_gather_off(const Unit& u, int r) const { return (unsigned)row_tok[u.li * 256 + r] * lda; }
};

typedef const f32x4 (&AccRef)[2][2][4][2];
#define EPI_ROWS for (int ai = 0; ai < 2; ++ai) _Pragma("unroll") for (int m = 0; m < 4; ++m)
#define EPI_ROWS_PIN for (int ai = 0; ai < 2; ++ai) _Pragma("unroll") for (int m = 0; m < 4; ++m, pin_mem(m))
__device__ __forceinline__ void pin_mem(int m) { (void)m; }
#define EPI_ROW_L (128 * ai + 64 * wr + 16 * m + fr)
#define EPI_COL_L(bj) (128 * (bj) + 32 * wc + 8 * fq)
__device__ __forceinline__ u32x4 pack8(const f32x4 a, const f32x4 b) { u32x4 o; o.x = cvt_pk_bf16(a.x, a.y); o.y = cvt_pk_bf16(a.z, a.w); o.z = cvt_pk_bf16(b.x, b.y); o.w = cvt_pk_bf16(b.z, b.w); return o; }
__device__ __forceinline__ void unpack8(const u32x4 v, f32x4& a, f32x4& b) { a = (f32x4){bf_lo(v.x), bf_hi(v.x), bf_lo(v.y), bf_hi(v.y)}; b = (f32x4){bf_lo(v.z), bf_hi(v.z), bf_lo(v.w), bf_hi(v.w)}; }
__device__ __forceinline__ f32x4 sigm4(f32x4 v) { return (f32x4){sigm(v.x), sigm(v.y), sigm(v.z), sigm(v.w)}; }

struct EpiS5U { bf16_t* UX; const LAS float* bias;
    __device__ __forceinline__ void operator()(AccRef acc, const Unit& u, int wr, int wc, int fr, int fq) const {
#pragma unroll
        for (int bj = 0; bj < 2; ++bj) { const int c = 256 * u.pn + EPI_COL_L(bj); const f32x4 b0 = *(const LAS f32x4*)(bias + c), b1 = *(const LAS f32x4*)(bias + c + 4); const int g = c >> 4, h0 = c & 15;
#pragma unroll
            EPI_ROWS { const int t = 256 * u.pm + EPI_ROW_L;
                st16_wt(UX + ((size_t)(g * 2048 + (t >> 4)) * 512 + (t & 15) * 16 + h0), __builtin_bit_cast(f32x4, pack8(acc[ai][bj][m][0] * INPROJ_DESCALE + b0, acc[ai][bj][m][1] * INPROJ_DESCALE + b1))); } }
    } };
struct EpiFT { bf16_t* UFT; const LAS float* bias  ;
    __device__ __forceinline__ void operator()(AccRef acc, const Unit& u, int wr, int wc, int fr, int fq) const {
#pragma unroll
        EPI_ROWS { const int ch = 256 * u.pm + EPI_ROW_L; const float bv = bias[ch];
#pragma unroll
            for (int bj = 0; bj < 2; ++bj) { const int t = 256 * u.pn + EPI_COL_L(bj);
                st16_wt(UFT + (size_t)ch * TOK + t, __builtin_bit_cast(f32x4, pack8(acc[ai][bj][m][0] * INPROJ_DESCALE + bv, acc[ai][bj][m][1] * INPROJ_DESCALE + bv))); } }
    } };
__device__ __forceinline__ f32x4 sig256_4(const f32x4 t) { return (f32x4){__builtin_amdgcn_rcpf(0.00390625f + __builtin_amdgcn_exp2f(t.x)), __builtin_amdgcn_rcpf(0.00390625f + __builtin_amdgcn_exp2f(t.y)),
                                                                          __builtin_amdgcn_rcpf(0.00390625f + __builtin_amdgcn_exp2f(t.z)), __builtin_amdgcn_rcpf(0.00390625f + __builtin_amdgcn_exp2f(t.w))}; }
struct EpiGate { unsigned char* GT; const LAS float* bias  ;
    __device__ __forceinline__ void operator()(AccRef acc, const Unit& u, int wr, int wc, int fr, int fq) const {
        const int c0 = 256 * u.pn + EPI_COL_L(0), c1 = 256 * u.pn + EPI_COL_L(1);
        constexpr float L2E = 1.4426950408889634f, ks = -INPROJ_DESCALE * L2E; static_assert(GATE_SCALE == 256.f, "sig256_4");
        const f32x4 b00 = *(const LAS f32x4*)(bias + c0) * -L2E - 8.f, b01 = *(const LAS f32x4*)(bias + c0 + 4) * -L2E - 8.f, b10 = *(const LAS f32x4*)(bias + c1) * -L2E - 8.f, b11 = *(const LAS f32x4*)(bias + c1 + 4) * -L2E - 8.f;
#pragma unroll
        EPI_ROWS { const int t = 256 * u.pm + EPI_ROW_L;
            *(u32x4*)(GT + (size_t)t * 2048 + 256 * u.pn + 64 * wc + 16 * fq) = (u32x4){pk4_fp8(sig256_4(acc[ai][0][m][0] * ks + b00), 1.f), pk4_fp8(sig256_4(acc[ai][0][m][1] * ks + b01), 1.f),
                                                                                          pk4_fp8(sig256_4(acc[ai][1][m][0] * ks + b10), 1.f), pk4_fp8(sig256_4(acc[ai][1][m][1] * ks + b11), 1.f)}; }
    } };
struct EpiInProj { EpiS5U e0; EpiFT e1; EpiGate e2; unsigned* arrive;
    __device__ __forceinline__ void operator()(AccRef acc, const Unit& u, int wr, int wc, int fr, int fq) const {
        if (u.z == 0) e0(acc, u, wr, wc, fr, fq);
        else if (u.z == 1) { e1(acc, u, wr, wc, fr, fq);
            asm volatile("s_waitcnt vmcnt(0)" ::: "memory");
            if ((fr | fq) == 0) (void)xb_add(arrive + 16 * (wr * 4 + wc), 1u); }
        else e2(acc, u, wr, wc, fr, fq); } };
struct EpiB16 { bf16_t* C; int ldc; size_t zC;
    __device__ __forceinline__ void operator()(AccRef acc, const Unit& u, int wr, int wc, int fr, int fq) const {
#pragma unroll
        for (int bj = 0; bj < 2; ++bj) { const int c = 256 * u.pn + EPI_COL_L(bj);
#pragma unroll
            EPI_ROWS { const int r = 256 * u.pm + EPI_ROW_L; *(u32x4*)(C + (size_t)u.z * zC + (size_t)r * ldc + c) = pack8(acc[ai][bj][m][0], acc[ai][bj][m][1]); } }
    } };
struct EpiF32 { float* C; int ldc; size_t zC;
    __device__ __forceinline__ void operator()(AccRef acc, const Unit& u, int wr, int wc, int fr, int fq) const {
#pragma unroll
        for (int bj = 0; bj < 2; ++bj) { const int c = 256 * u.pn + EPI_COL_L(bj);
#pragma unroll
            EPI_ROWS { const int r = 256 * u.pm + EPI_ROW_L; float* p = C + (size_t)u.z * zC + (size_t)r * ldc + c;
                *(f32x4*)p = acc[ai][bj][m][0]; *(f32x4*)(p + 4) = acc[ai][bj][m][1]; } }
    } };
struct EpiRouter { float* LG; LAS float* sel; const float* rb;
    __device__ __forceinline__ void operator()(AccRef acc, const Unit& u, int wr, int wc, int fr, int fq) const {
        const f32x4 rbv[2][2] = {{*(const f32x4*)(rb + EPI_COL_L(0)), *(const f32x4*)(rb + EPI_COL_L(0) + 4)}, {*(const f32x4*)(rb + EPI_COL_L(1)), *(const f32x4*)(rb + EPI_COL_L(1) + 4)}};
        asm volatile("s_waitcnt vmcnt(0)" ::: "memory"); __builtin_amdgcn_s_barrier();
#pragma unroll
        for (int bj = 0; bj < 2; ++bj) { const int c = EPI_COL_L(bj); const f32x4 b0 = rbv[bj][0], b1 = rbv[bj][1];
#pragma unroll
            for (int m = 0; m < 4; ++m) { const int r = 64 * wr + 16 * m + fr; LAS float* row = sel + r * 256; const f32x4 v0 = acc[0][bj][m][0], v1 = acc[0][bj][m][1];
                row[(c + 0 + r) & 255] = sigm(v0.x) + b0.x; row[(c + 1 + r) & 255] = sigm(v0.y) + b0.y; row[(c + 2 + r) & 255] = sigm(v0.z) + b0.z; row[(c + 3 + r) & 255] = sigm(v0.w) + b0.w;
                row[(c + 4 + r) & 255] = sigm(v1.x) + b1.x; row[(c + 5 + r) & 255] = sigm(v1.y) + b1.y; row[(c + 6 + r) & 255] = sigm(v1.z) + b1.z; row[(c + 7 + r) & 255] = sigm(v1.w) + b1.w;
                float* g = LG + (size_t)(256 * u.pm + 128 + r) * 256 + c; st16_wt(g, acc[1][bj][m][0]); st16_wt(g + 4, acc[1][bj][m][1]); } }
    } };
struct EpiS5Y { unsigned char* Z;
    __device__ __forceinline__ void operator()(AccRef acc, const Unit& u, int wr, int wc, int fr, int fq) const {
#pragma unroll
        for (int bj = 0; bj < 2; ++bj) { const int c = EPI_COL_L(bj), i = c >> 4, h0 = c & 15;
#pragma unroll
            EPI_ROWS { const int rr = 256 * u.pm + EPI_ROW_L; const int t = rr * 16 + i; f32x4 a = acc[ai][bj][m][0], b = acc[ai][bj][m][1];
                a = (f32x4){gelu_tanh(a.x), gelu_tanh(a.y), gelu_tanh(a.z), gelu_tanh(a.w)}; b = (f32x4){gelu_tanh(b.x), gelu_tanh(b.y), gelu_tanh(b.z), gelu_tanh(b.w)};
                *(u32x2*)(Z + (size_t)t * 512 + u.z * 16 + h0) = (u32x2){pk4_fp8(a, Z_SCALE), pk4_fp8(b, Z_SCALE)}; } }
    } };
struct EpiGlu { unsigned char* P; const LAS float* bias;
    __device__ __forceinline__ void operator()(AccRef acc, const Unit& u, int wr, int wc, int fr, int fq) const {
        const int oc = 128 * u.pn + 32 * wc + 8 * fq;
        const f32x4 a0 = *(const LAS f32x4*)(bias + oc), a1 = *(const LAS f32x4*)(bias + oc + 4), b0 = *(const LAS f32x4*)(bias + 1024 + oc) * -1.4426950408889634f - 3.f, b1 = *(const LAS f32x4*)(bias + 1024 + oc + 4) * -1.4426950408889634f - 3.f;
        static_assert(P_SCALE == 8.f, "EpiGlu folds P_SCALE into the reciprocal");
#pragma unroll
        EPI_ROWS { const int t = 256 * u.pm + EPI_ROW_L;
            constexpr float ds = 1.f / (W_SCALE * Z_SCALE);
            const f32x4 tb0 = acc[ai][1][m][0] * (-ds * 1.4426950408889634f) + b0, tb1 = acc[ai][1][m][1] * (-ds * 1.4426950408889634f) + b1;
            const f32x4 q0 = {__builtin_amdgcn_rcpf(0.125f + __builtin_amdgcn_exp2f(tb0.x)), __builtin_amdgcn_rcpf(0.125f + __builtin_amdgcn_exp2f(tb0.y)), __builtin_amdgcn_rcpf(0.125f + __builtin_amdgcn_exp2f(tb0.z)), __builtin_amdgcn_rcpf(0.125f + __builtin_amdgcn_exp2f(tb0.w))};
            const f32x4 q1 = {__builtin_amdgcn_rcpf(0.125f + __builtin_amdgcn_exp2f(tb1.x)), __builtin_amdgcn_rcpf(0.125f + __builtin_amdgcn_exp2f(tb1.y)), __builtin_amdgcn_rcpf(0.125f + __builtin_amdgcn_exp2f(tb1.z)), __builtin_amdgcn_rcpf(0.125f + __builtin_amdgcn_exp2f(tb1.w))};
            const f32x4 v0 = (acc[ai][0][m][0] * ds + a0) * q0, v1 = (acc[ai][0][m][1] * ds + a1) * q1;
            *(u32x2*)(P + (size_t)t * 1024 + 256 * (u.pn >> 1) + 64 * wc + 16 * fq + 8 * (u.pn & 1)) = (u32x2){pk4_fp8(v0, 1.f), pk4_fp8(v1, 1.f)}; }
    } };
struct EpiMerge { unsigned char* MG; const unsigned char* P; const unsigned char* GT; const LAS float* bias;
    __device__ __forceinline__ void operator()(AccRef acc, const Unit& u, int wr, int wc, int fr, int fq) const {
        const int c0 = 256 * u.pn + EPI_COL_L(0), c1 = 256 * u.pn + EPI_COL_L(1), pq = 256 * u.pn + 64 * wc + 16 * fq;
        const f32x4 b00 = *(const LAS f32x4*)(bias + c0) * P_SCALE, b01 = *(const LAS f32x4*)(bias + c0 + 4) * P_SCALE, b10 = *(const LAS f32x4*)(bias + c1) * P_SCALE, b11 = *(const LAS f32x4*)(bias + c1 + 4) * P_SCALE;
        constexpr float ka = P_SCALE / (ZC_SCALE * WFP_SCALE), ko = MG_SCALE / (GATE_SCALE * P_SCALE);
#pragma unroll
        EPI_ROWS_PIN { const int t = 256 * u.pm + EPI_ROW_L; const u32x4 gf = *(const u32x4*)(GT + (size_t)t * 2048 + 1024 + pq), gs = *(const u32x4*)(GT + (size_t)t * 2048 + pq), pp = *(const u32x4*)(P + (size_t)t * 1024 + pq);
            *(u32x2*)(MG + (size_t)t * 1024 + c0) = (u32x2){pk4_fp8(unpk4_fp8(gs.x) * unpk4_fp8(pp.x) + unpk4_fp8(gf.x) * (acc[ai][0][m][0] * ka + b00), ko), pk4_fp8(unpk4_fp8(gs.y) * unpk4_fp8(pp.y) + unpk4_fp8(gf.y) * (acc[ai][0][m][1] * ka + b01), ko)};
            *(u32x2*)(MG + (size_t)t * 1024 + c1) = (u32x2){pk4_fp8(unpk4_fp8(gs.z) * unpk4_fp8(pp.z) + unpk4_fp8(gf.z) * (acc[ai][1][m][0] * ka + b10), ko), pk4_fp8(unpk4_fp8(gs.w) * unpk4_fp8(pp.w) + unpk4_fp8(gf.w) * (acc[ai][1][m][1] * ka + b11), ko)}; }
    } };
struct EpiOut { bf16_t* R1; const float* X; const float* mod; const float* bias;
    __device__ __forceinline__ void operator()(AccRef acc, const Unit& u, int wr, int wc, int fr, int fq) const {
        const int b = (256 * u.pm) / SEQ;
#pragma unroll
        for (int bj = 0; bj < 2; ++bj) { const int c = 256 * u.pn + EPI_COL_L(bj); const f32x4 b0 = *(const f32x4*)(bias + c), b1 = *(const f32x4*)(bias + c + 4);
            const f32x4 g0 = *(const f32x4*)(mod + b * 6144 + 2048 + c), g1 = *(const f32x4*)(mod + b * 6144 + 2048 + c + 4);
#pragma unroll
            EPI_ROWS_PIN { const size_t o = (size_t)(256 * u.pm + EPI_ROW_L) * 1024 + c; const f32x4 x0 = *(const f32x4*)(X + o), x1 = *(const f32x4*)(X + o + 4);
                *(u32x4*)(R1 + o) = pack8(x0 * ALPHA + g0 * (acc[ai][bj][m][0] * (1.f / (W_SCALE * MG_SCALE)) + b0), x1 * ALPHA + g1 * (acc[ai][bj][m][1] * (1.f / (W_SCALE * MG_SCALE)) + b1)); } }
    } };
struct EpiSwi { bf16_t* HID;
    __device__ __forceinline__ void operator()(AccRef acc, const Unit& u, int wr, int wc, int fr, int fq) const {
        const int oc = 128 * u.pn + 32 * wc + 8 * fq;
#pragma unroll
        EPI_ROWS { const int r = 256 * u.pm + EPI_ROW_L; const f32x4 g0 = acc[ai][0][m][0], g1 = acc[ai][0][m][1];
            *(u32x4*)(HID + (size_t)r * 256 + oc) = pack8(g0 * sigm4(g0) * acc[ai][1][m][0], g1 * sigm4(g1) * acc[ai][1][m][1]); }
    } };
struct EpiSwi8 { unsigned char* HID; int row0; float inv;
    __device__ __forceinline__ void operator()(AccRef acc, const Unit& u, int wr, int wc, int fr, int fq) const {
        const int oc = 128 * u.pn + 32 * wc + 8 * fq;
        const float kx = -inv * 1.4426950408889634f, C = 1.f / (HID_SCALE * inv * inv), lC = __builtin_log2f(C);
#pragma unroll
        EPI_ROWS { const int r = row0 + 256 * u.pm + EPI_ROW_L; const f32x4 ag0 = acc[ai][0][m][0], ag1 = acc[ai][0][m][1], t0 = ag0 * kx + lC, t1 = ag1 * kx + lC;
            const f32x4 r0 = {__builtin_amdgcn_rcpf(C + __builtin_amdgcn_exp2f(t0.x)), __builtin_amdgcn_rcpf(C + __builtin_amdgcn_exp2f(t0.y)), __builtin_amdgcn_rcpf(C + __builtin_amdgcn_exp2f(t0.z)), __builtin_amdgcn_rcpf(C + __builtin_amdgcn_exp2f(t0.w))};
            const f32x4 r1 = {__builtin_amdgcn_rcpf(C + __builtin_amdgcn_exp2f(t1.x)), __builtin_amdgcn_rcpf(C + __builtin_amdgcn_exp2f(t1.y)), __builtin_amdgcn_rcpf(C + __builtin_amdgcn_exp2f(t1.z)), __builtin_amdgcn_rcpf(C + __builtin_amdgcn_exp2f(t1.w))};
            *(u32x2*)(HID + (size_t)r * 256 + oc) = (u32x2){pk4_fp8(ag0 * acc[ai][1][m][0] * r0, 1.f), pk4_fp8(ag1 * acc[ai][1][m][1] * r1, 1.f)}; }
    } };
struct EpiShDn { bf16_t* SH;
    __device__ __forceinline__ void operator()(AccRef acc, const Unit& u, int wr, int wc, int fr, int fq) const {
#pragma unroll
        for (int bj = 0; bj < 2; ++bj) { const int c = 256 * u.pn + EPI_COL_L(bj);
#pragma unroll
            EPI_ROWS { *(u32x4*)(SH + (size_t)(256 * u.pm + EPI_ROW_L) * 1024 + c) = pack8(acc[ai][bj][m][0], acc[ai][bj][m][1]); } }
    } };
struct EpiExDn { unsigned char* YS; const LAS unsigned* tab; int dbg = 0;
    __device__ __forceinline__ void operator()(AccRef acc, const Unit& u, int wr, int wc, int fr, int fq) const {
#pragma unroll
        EPI_ROWS { const unsigned w = tab[u.li * 256 + EPI_ROW_L]; const unsigned slot = w & 0x7FFFFu; const float gt = (float)(w >> 19) * ((1.f / 3000.f) * YS_SCALE / (W_SCALE * HID_SCALE));
            u32x4 o;
            if (dbg & 4) o = (u32x4){__float_as_uint(acc[ai][0][m][0].x), __float_as_uint(acc[ai][0][m][1].x), __float_as_uint(acc[ai][1][m][0].x), __float_as_uint(acc[ai][1][m][1].x)};
            else o = (u32x4){pk4_fp8(acc[ai][0][m][0], gt), pk4_fp8(acc[ai][0][m][1], gt), pk4_fp8(acc[ai][1][m][0], gt), pk4_fp8(acc[ai][1][m][1], gt)};
#if P13_NT2
            *(u32x4*)(YS + (size_t)slot * 1024 + 256 * u.pn + 64 * wc + 16 * fq) = o; }
#else
            if (slot < (unsigned)(TOK * TOPK + TOK)) *(u32x4*)(YS + (size_t)slot * 1024 + 256 * u.pn + 64 * wc + 16 * fq) = o; }
#endif
    } };

struct Args { const float* in[32]; float* out; unsigned char* ws; int ph_lo, ph_hi, flags, pad_; };
enum { I_X = 0, I_C, I_WADA, I_BADA, I_WIN, I_BIN, I_LRE, I_LIM, I_LDT, I_BRE, I_BIM, I_CRE, I_CIM, I_S5D, I_WGLU, I_BGLU, I_WF, I_BF, I_WOUT, I_BOUT, I_LN1G, I_LN1B,
       I_WRT, I_RBIAS, I_EG, I_EU, I_ED, I_SHG, I_SHU, I_SHD, I_LN2G, I_LN2B };
struct Frame { LAS unsigned char* lds; int tid, lane, wave, vcu, G; };

__device__ __forceinline__ void transpose_item(const float* W, int K, int N, int k0, int n0, bf16_t* dst, int drow0, LAS unsigned* scr, int lane) {
    const float* src = W + (size_t)k0 * N + n0 + lane;
    float v[64];
#pragma unroll
    for (int i = 0; i < 64; ++i) v[i] = src[(size_t)i * N];
#pragma unroll
    for (int i = 0; i < 32; ++i) scr[i * 65 + lane] = cvt_pk_bf16(v[2 * i], v[2 * i + 1]);
    LDS_WAIT(); asm volatile("" ::: "memory");
    const int c = lane & 7;
#pragma unroll
    for (int j = 0; j < 8; ++j) { const int n = (lane >> 3) + 8 * j; const LAS unsigned* s = scr + (4 * c) * 65 + n;
        u32x4 o; o.x = s[0]; o.y = s[65]; o.z = s[130]; o.w = s[195];
        *(u32x4*)(dst + (size_t)(drow0 + n) * K + k0 + 8 * c) = o; }
    LDS_WAIT(); asm volatile("" ::: "memory");
}
__device__ __forceinline__ void transpose_item_f8(const float* W, int K, int N, int k0, int n0, unsigned char* dst, int drow0, LAS unsigned* scr, int lane, float scale) {
    const float* src = W + (size_t)k0 * N + n0 + lane;
#pragma unroll
    for (int hf = 0; hf < 2; ++hf) { float v[64];
#pragma unroll
        for (int i = 0; i < 64; ++i) v[i] = src[(size_t)(hf * 64 + i) * N];
#pragma unroll
        for (int i = 0; i < 16; ++i) scr[(hf * 16 + i) * 65 + lane] = pk4_fp8((f32x4){v[4 * i], v[4 * i + 1], v[4 * i + 2], v[4 * i + 3]}, scale); }
    LDS_WAIT(); asm volatile("" ::: "memory");
    const int c = lane & 7;
#pragma unroll
    for (int j = 0; j < 8; ++j) { const int n = (lane >> 3) + 8 * j; const LAS unsigned* q = scr + (4 * c) * 65 + n;
        u32x4 o; o.x = q[0]; o.y = q[65]; o.z = q[130]; o.w = q[195];
        *(u32x4*)(dst + (size_t)(drow0 + n) * K + k0 + 16 * c) = o; }
    LDS_WAIT(); asm volatile("" ::: "memory");
}
__device__ __forceinline__ void s5_matrices(const Frame& F, const Args& a, int g, int sl, bf16_t* MB, bf16_t* TC) {
    LAS float* L = (LAS float*)F.lds;
    LAS float* pwr = L;
    LAS float* pwi = L + 2176;
    LAS float* bbr = L + 4352;
    LAS float* bbi = L + 6400;
    LAS float* cr = L + 8448;
    LAS float* ci = L + 10496;
    LAS float* Kd = L + 12544;
    LAS float* prm = L + 20736;
    const int tid = F.tid;
    __syncthreads();
    if (tid < 128) { const int d = tid >> 6, p = tid & 63; prm[tid] = a.in[I_LRE][(d * NGRP + g) * 64 + p]; prm[128 + tid] = a.in[I_LIM][(d * NGRP + g) * 64 + p]; }
    else if (tid < 130) prm[256 + tid - 128] = expf(a.in[I_LDT][(tid - 128) * NGRP + g]);
    else if (tid < 146) prm[272 + tid - 130] = a.in[I_S5D][g * 16 + tid - 130];
    __syncthreads();
    for (int idx = tid; idx < 2 * 17 * 64; idx += 512) { const int d = idx / (17 * 64), e = (idx / 64) % 17, p = idx % 64;
        const float lr = prm[d * 64 + p], li = prm[128 + d * 64 + p], dt = prm[256 + d];
        const float mg = __expf(lr * dt * (float)e); float sn, cs; fast_sincos(li * dt * (float)e, sn, cs);
        pwr[idx] = mg * cs; pwi[idx] = mg * sn; }
    for (int idx = tid; idx < 2 * 64 * 16; idx += 512) { const int d = idx / 1024, p = (idx / 16) % 64, h = idx % 16;
        const float lr = prm[d * 64 + p], li = prm[128 + d * 64 + p], dt = prm[256 + d];
        const float mg = __expf(lr * dt); float sn, cs; fast_sincos(li * dt, sn, cs);
        const float abr = mg * cs, abi = mg * sn, den = lr * lr + li * li, nr = abr - 1.f;
        const float cfr = (nr * lr + abi * li) / den, cfi = (abi * lr - nr * li) / den;
        const size_t bo = ((size_t)(d * NGRP + g) * 64 + p) * 16 + h; const float br = a.in[I_BRE][bo], bi = a.in[I_BIM][bo];
        bbr[idx] = cfr * br - cfi * bi; bbi[idx] = cfr * bi + cfi * br; }
    for (int idx = tid; idx < 2 * 16 * 64; idx += 512) { const int d = idx / 1024, r = idx % 1024, h = r >> 6, p = r & 63;
        const size_t co = (size_t)(d * NGRP + g) * 1024 + r; cr[(d * 64 + p) * 16 + h] = a.in[I_CRE][co]; ci[(d * 64 + p) * 16 + h] = a.in[I_CIM][co]; }
    __syncthreads();
    {   const int d = tid >> 8, dl = (tid >> 4) & 15, h = tid & 15; float acc16[16];
#pragma unroll
        for (int q = 0; q < 16; ++q) acc16[q] = 0.f;
        for (int p = 0; p < 64; ++p) { const float wr_ = pwr[(d * 17 + dl) * 64 + p], wi_ = pwi[(d * 17 + dl) * 64 + p], c_r = cr[(d * 64 + p) * 16 + h], c_i = ci[(d * 64 + p) * 16 + h];
            const float qr = c_r * wr_ - c_i * wi_, qi = c_r * wi_ + c_i * wr_;
#pragma unroll
            for (int q4 = 0; q4 < 4; ++q4) { const f32x4 br = *(const LAS f32x4*)(bbr + (d * 64 + p) * 16 + 4 * q4), bi = *(const LAS f32x4*)(bbi + (d * 64 + p) * 16 + 4 * q4);
                acc16[4 * q4 + 0] += qr * br.x - qi * bi.x; acc16[4 * q4 + 1] += qr * br.y - qi * bi.y; acc16[4 * q4 + 2] += qr * br.z - qi * bi.z; acc16[4 * q4 + 3] += qr * br.w - qi * bi.w; } }
#pragma unroll
        for (int q = 0; q < 16; ++q) Kd[((d * 16 + dl) * 16 + h) * 16 + q] = acc16[q]; }
    __syncthreads();
    for (int idx = tid; idx < 32 * 128; idx += 512) { const int n = 32 * sl + idx / 128, k = (idx % 128) * 2; const int d = n >> 7, part = (n >> 6) & 1, p = n & 63, j = k >> 4, hp = k & 15;
        const int e = d == 0 ? 15 - j : j; const float wr_ = pwr[(d * 17 + e) * 64 + p], wi_ = pwi[(d * 17 + e) * 64 + p];
        float v[2];
#pragma unroll
        for (int q = 0; q < 2; ++q) { const float br = bbr[(d * 64 + p) * 16 + hp + q], bi = bbi[(d * 64 + p) * 16 + hp + q]; v[q] = part == 0 ? wr_ * br - wi_ * bi : wr_ * bi + wi_ * br; }
        *(unsigned*)(MB + (size_t)n * 256 + k) = cvt_pk_bf16(v[0], v[1]); }
    for (int idx = tid; idx < 32 * 256; idx += 512) { const int n = 32 * sl + idx / 256, k = (idx % 256) * 2; const int i = n >> 4, h = n & 15; float v[2];
        if (k < 256) { const int j = k >> 4, hp = k & 15;
#pragma unroll
            for (int q = 0; q < 2; ++q) { float s = 0.f; if (i >= j) s += Kd[((0 * 16 + (i - j)) * 16 + h) * 16 + hp + q]; if (j >= i) s += Kd[((1 * 16 + (j - i)) * 16 + h) * 16 + hp + q];
                if (i == j && h == hp + q) s += prm[272 + h]; v[q] = s; } }
        else { const int kk = k - 256, d = kk >> 7, part = (kk >> 6) & 1, p0 = kk & 63; const int e = d == 0 ? i + 1 : 16 - i;
#pragma unroll
            for (int q = 0; q < 2; ++q) { const int p = p0 + q; const float wr_ = pwr[(d * 17 + e) * 64 + p], wi_ = pwi[(d * 17 + e) * 64 + p], c_r = cr[(d * 64 + p) * 16 + h], c_i = ci[(d * 64 + p) * 16 + h];
                v[q] = part == 0 ? (c_r * wr_ - c_i * wi_) : -(c_r * wi_ + c_i * wr_); } }
        *(unsigned*)(TC + (size_t)n * 512 + k) = cvt_pk_bf16(v[0], v[1]); }
    __syncthreads();
}
__device__ __forceinline__ void fourier_weight_item(const Frame& F, const float* Wf, unsigned char* WFP, int item) {
    LAS float* wl = (LAS float*)F.lds;
    LAS float* ct = wl + 2048;
    const int g4 = item >> 6, n0 = (item & 63) * 16, tid = F.tid;
    __syncthreads();
    { const int l = tid >> 2, n = (tid & 3) * 4; *(LAS f32x4*)(wl + l * 16 + n) = *(const f32x4*)(Wf + (size_t)(g4 * 128 + l) * 1024 + n0 + n); }
    if (tid < 128) ct[tid] = cospif((float)tid * (1.f / 64.f));
    __syncthreads();
    const float scale = 1.f / 724.0773439350247f;
    const int pw = tid & 255, part = pw >> 7, w = pw & 127, nh = tid >> 8;
    f32x4 a0 = {0.f, 0.f, 0.f, 0.f}, a1 = {0.f, 0.f, 0.f, 0.f};
    for (int l = 0; l < 128; ++l) { const int ph = (l * w) & 127; const float tr = part == 0 ? ct[ph] : -ct[(ph + 96) & 127];
        a0 += tr * *(const LAS f32x4*)(wl + l * 16 + nh * 8); a1 += tr * *(const LAS f32x4*)(wl + l * 16 + nh * 8 + 4); }
    unsigned char* o = WFP + (size_t)(n0 + nh * 8) * 1024 + part * 512 + g4 * 128 + w;
    const unsigned q0 = pk4_fp8(a0, scale * WFP_SCALE), q1 = pk4_fp8(a1, scale * WFP_SCALE);
    o[0 * 1024] = (unsigned char)(q0 & 0xffu); o[1 * 1024] = (unsigned char)((q0 >> 8) & 0xffu); o[2 * 1024] = (unsigned char)((q0 >> 16) & 0xffu); o[3 * 1024] = (unsigned char)(q0 >> 24);
    o[4 * 1024] = (unsigned char)(q1 & 0xffu); o[5 * 1024] = (unsigned char)((q1 >> 8) & 0xffu); o[6 * 1024] = (unsigned char)((q1 >> 16) & 0xffu); o[7 * 1024] = (unsigned char)(q1 >> 24);
    __syncthreads();
}

__device__ __forceinline__ void p0_small(const Frame& F, const Args& a) {
    unsigned char* ws = a.ws; const int part = 28;
    if (part & 4) {
    for (int it = F.vcu; it < NGRP * 8; it += F.G) s5_matrices(F, a, it >> 3, it & 7, (bf16_t*)(ws + WS_S5MB) + (size_t)(it >> 3) * 65536, (bf16_t*)(ws + WS_S5TC) + (size_t)(it >> 3) * 131072);
    }
    if (part & 8) {
    for (int it = F.vcu; it < 256; it += F.G) fourier_weight_item(F, a.in[I_WF], ws + WS_WFP, it);
    }
    if (part & 16) {
    {   bf16_t* TB = (bf16_t*)(ws + WS_DFT);
        const int nth = F.G * 512, me = F.vcu * 512 + F.tid;
        for (int q = me; q < 16 * 512 * 64; q += nth) { const int k1 = q >> 15, m = (q >> 6) & 511, K0 = (q & 63) * 8, prt = m >> 8, k2 = m & 255, yp = K0 >> 8, s20 = K0 & 255, k = k1 + 16 * k2; float v[8];
#pragma unroll
            for (int e = 0; e < 8; ++e) { const float rev = (float)((k * (s20 + e)) & 4095) * (1.f / 4096.f); const float fr = __builtin_amdgcn_cosf(rev), fs = __builtin_amdgcn_sinf(rev); v[e] = prt == 0 ? (yp == 0 ? fr : fs) : (yp == 0 ? fs : -fr); }
            *(u32x4*)(TB + (size_t)(k1 * 512 + m) * 512 + K0) = (u32x4){cvt_pk_bf16(v[0], v[1]), cvt_pk_bf16(v[2], v[3]), cvt_pk_bf16(v[4], v[5]), cvt_pk_bf16(v[6], v[7])}; }
    }
    }
}
__device__ __forceinline__ void p0_prologue(const Frame& F, const Args& a) {
    unsigned char* ws = a.ws;
    LAS unsigned* scr = (LAS unsigned*)(F.lds + F.wave * 8448);
    LAS float* sc = (LAS float*)(F.lds + 69632);
    LAS int* ctr = (LAS int*)(F.lds + 69632 + 32768);
    __syncthreads();
    {   float cv[16];
#pragma unroll
        for (int k = 0; k < 16; ++k) cv[k] = a.in[I_C][F.tid + 512 * k];
#pragma unroll
        for (int k = 0; k < 16; ++k) { const int i = F.tid + 512 * k; sc[(i & 1023) * 8 + (i >> 10)] = cv[k] * sigm(cv[k]); } }
    if (F.tid == 0) *ctr = 0;
    __syncthreads();
    constexpr int IT_WIN = 8 * 48, IT_GLU = 4 * 32, IT_OUT = 8 * 16, IT_RT = 16 * 4, IT_SH = 8 * 4, IT_SHD = 2 * 16, IT_SMALL = IT_WIN + IT_GLU + IT_OUT + IT_RT + 2 * IT_SH + IT_SHD;
    constexpr int IT_ALL = IT_SMALL, IT_ADA = 96 * 8;
    const int a_lo = (int)((long long)IT_ADA * F.vcu / F.G), n_ada = (int)((long long)IT_ADA * (F.vcu + 1) / F.G) - a_lo;
    const int t_lo = (int)((long long)IT_ALL * F.vcu / F.G), n_loc = n_ada + (int)((long long)IT_ALL * (F.vcu + 1) / F.G) - t_lo;
    float* modp = (float*)(ws + WS_MODP);
    for (;;) {
        int li = 0; if (F.lane == 0) li = __hip_atomic_fetch_add(ctr, 1, __ATOMIC_RELAXED, __HIP_MEMORY_SCOPE_WORKGROUP);
        li = __builtin_amdgcn_readfirstlane(li);
        if (li >= n_loc) break;
        if (li < n_ada) { const int it = a_lo + li, cb = it % 96, kc = it / 96, j = cb * 64 + F.lane; f32x4 s0 = {0.f, 0.f, 0.f, 0.f}, s1 = {0.f, 0.f, 0.f, 0.f};
            const float* wp = a.in[I_WADA] + (size_t)(kc * 128) * 6144 + j;
#pragma unroll 32
            for (int k = 0; k < 128; ++k) { const float w = wp[(size_t)k * 6144]; s0 += w * *(const LAS f32x4*)(sc + (kc * 128 + k) * 8); s1 += w * *(const LAS f32x4*)(sc + (kc * 128 + k) * 8 + 4); }
#pragma unroll
            for (int b = 0; b < 4; ++b) { modp[(size_t)(kc * 8 + b) * 6144 + j] = s0[b]; modp[(size_t)(kc * 8 + 4 + b) * 6144 + j] = s1[b]; }
            continue; }
        int r = t_lo + (li - n_ada);
        if (r < IT_WIN) { const int kb = r / 48, nb = r % 48; transpose_item_f8(a.in[I_WIN], 1024, 3072, kb * 128, nb * 64, ws + WS_WIN, nb * 64, scr, F.lane, W_SCALE); continue; } r -= IT_WIN;
        if (r < IT_GLU) { const int kb = r / 32, nb = r % 32, n0 = nb * 64; const int dr = n0 < 1024 ? (n0 >> 7) * 256 + (n0 & 127) : ((n0 - 1024) >> 7) * 256 + 128 + (n0 & 127);
            transpose_item_f8(a.in[I_WGLU], 512, 2048, kb * 128, n0, ws + WS_WGLU, dr, scr, F.lane, W_SCALE); continue; } r -= IT_GLU;
        if (r < IT_OUT) { const int kb = r / 16, nb = r % 16; transpose_item_f8(a.in[I_WOUT], 1024, 1024, kb * 128, nb * 64, ws + WS_WOUT, nb * 64, scr, F.lane, W_SCALE); continue; } r -= IT_OUT;
        if (r < IT_RT) { const int kb = r / 4, nb = r % 4; transpose_item(a.in[I_WRT], 1024, 256, kb * 64, nb * 64, (bf16_t*)(ws + WS_WRT), nb * 64, scr, F.lane); continue; } r -= IT_RT;
        if (r < 2 * IT_SH) { const int up = r / IT_SH, q = r % IT_SH, kb = q / 4, nb = q % 4, n0 = nb * 64;
            transpose_item_f8(a.in[up ? I_SHU : I_SHG], 1024, 256, kb * 128, n0, ws + WS_WSHGU, (n0 >> 7) * 256 + up * 128 + (n0 & 127), scr, F.lane, W_SCALE); continue; } r -= 2 * IT_SH;
        if (r < IT_SHD) { const int kb = r / 16, nb = r % 16; transpose_item_f8(a.in[I_SHD], 256, 1024, kb * 128, nb * 64, ws + WS_EDN + (size_t)NEXP * 262144, nb * 64, scr, F.lane, W_SCALE); continue; } r -= IT_SHD;
    }
    asm volatile("s_waitcnt vmcnt(0)" ::: "memory");
    __syncthreads();
    if (F.tid == 0) { __builtin_amdgcn_fence(__ATOMIC_RELEASE, "agent"); asm volatile("s_waitcnt vmcnt(0)" ::: "memory"); (void)xb_add((unsigned*)(ws + WS_CTL) + CW_ADA, 1u); }
    {   constexpr int NIT = NEXP * 3 * 8;
        const int lo = (int)((long long)NIT * F.vcu / F.G), hi = (int)((long long)NIT * (F.vcu + 1) / F.G);
        const int w = F.wave, l = F.lane;
        auto ld = [&](f32x4 (&v)[16], int idx) { const float* src; int ldn;
            if (idx < NEXP * 16) { const int mat = idx >> 3, kb = idx & 7; src = a.in[(mat & 1) ? I_EU : I_EG] + (size_t)(mat >> 1) * 262144 + (size_t)kb * 128 * 256; ldn = 256; }
            else { const int j = idx - NEXP * 16, e = j >> 3, kb = (j >> 2) & 1, nb = j & 3; src = a.in[I_ED] + (size_t)e * 262144 + (size_t)kb * 128 * 1024 + nb * 256; ldn = 1024; }
            src += (size_t)(16 * w) * ldn + 4 * l;
#pragma unroll
            for (int i = 0; i < 16; ++i) v[i] = *(const f32x4*)(src + (size_t)i * ldn); };
        auto cw = [&](const f32x4 (&v)[16], LAS unsigned char* buf) {
#pragma unroll
            for (int q = 0; q < 4; ++q) { u32x4 o;
#pragma unroll
                for (int cq = 0; cq < 4; ++cq) o[cq] = pk4_fp8((f32x4){v[4 * cq][q], v[4 * cq + 1][q], v[4 * cq + 2][q], v[4 * cq + 3][q]}, W_SCALE);
                *(LAS u32x4*)(buf + (l + 64 * q) * 128 + ((w ^ ((l >> 1) & 7)) << 4)) = o; } };
        auto rs = [&](int idx, const LAS unsigned char* buf) { unsigned char* dst; int gu;
            if (idx < NEXP * 16) { const int mat = idx >> 3, kb = idx & 7; dst = ws + WS_EGU + (size_t)(mat >> 1) * 524288 + (size_t)((mat & 1) * 128) * 1024 + kb * 128; gu = 1; }
            else { const int j = idx - NEXP * 16, e = j >> 3, kb = (j >> 2) & 1, nb = j & 3; dst = ws + WS_EDN + (size_t)e * 262144 + (size_t)(nb * 256) * 256 + kb * 128; gu = 0; }
#pragma unroll
            for (int pq = 0; pq < 4; ++pq) { const int pos = w * 32 + pq * 8 + (l >> 3), cq = l & 7, n = 4 * (pos & 63) + (pos >> 6);
                const u32x4 v = *(const LAS u32x4*)(buf + pos * 128 + ((cq ^ ((pos >> 1) & 7)) << 4));
                const size_t ro = gu ? (size_t)((n >> 7) * 256 + (n & 127)) * 1024 : (size_t)n * 256;
                *(u32x4*)(dst + ro + 16 * cq) = v; } };
        LAS unsigned char* b0 = F.lds; LAS unsigned char* b1 = F.lds + 32768;
        f32x4 va[16], vb[16];
        if (lo < hi) ld(va, lo);
        const int pause_it = lo + 2 * (F.vcu & 7);
        for (int it = lo; it < hi; it += 2) {
            if (it == pause_it) { __syncthreads(); p0_small(F, a); __syncthreads(); }
            CFENCE(); if (it + 1 < hi) ld(vb, it + 1); CFENCE();
            cw(va, b0); __syncthreads(); rs(it, b0);
            CFENCE(); if (it + 2 < hi) ld(va, it + 2); CFENCE();
            if (it + 1 < hi) { cw(vb, b1); __syncthreads(); rs(it + 1, b1); }
        }
        __syncthreads();
    }
}

__device__ __forceinline__ void p1_load(f32x4 (&v)[4][4], const float* X, const int t0, const int lane) {
#pragma unroll
    for (int q = 0; q < 4; ++q) { const f32x4* xr = (const f32x4*)(X + (size_t)(t0 + q) * 1024) + lane;
#pragma unroll
        for (int j = 0; j < 4; ++j) v[q][j] = xr[64 * j]; }
}
__device__ __forceinline__ void p1_proc(f32x4 (&v)[4][4], unsigned char* U8, const LAS float* sh, const int t0, const int lane) {
#pragma unroll
    for (int q = 0; q < 4; ++q) { const int t = t0 + q; float s = 0.f;
#pragma unroll
        for (int j = 0; j < 4; ++j) s += (v[q][j].x + v[q][j].y) + (v[q][j].z + v[q][j].w);
        const float mean = wave_sum(s) * (1.f / 1024.f); float s2 = 0.f;
#pragma unroll
        for (int j = 0; j < 4; ++j) { v[q][j] = v[q][j] - mean; s2 += (v[q][j].x * v[q][j].x + v[q][j].y * v[q][j].y) + (v[q][j].z * v[q][j].z + v[q][j].w * v[q][j].w); }
        const float rstd = 1.f / sqrtf(wave_sum(s2) * (1.f / 1024.f) + LN_EPS);
        unsigned* o4 = (unsigned*)(U8 + (size_t)t * 1024) + lane;
#pragma unroll
        for (int j = 0; j < 4; ++j) { const int c = 4 * lane + 256 * j; const f32x4 s1 = *(const LAS f32x4*)(sh + c), c1 = *(const LAS f32x4*)(sh + 1024 + c);
            const f32x4 y = v[q][j] * rstd * (c1 + 1.f) + s1; o4[64 * j] = pk4_fp8(y, U_SCALE); } }
}
__device__ __forceinline__ void p1_modulate(const Frame& F, const Args& a) {
    unsigned char* ws = a.ws; const float* modp = (const float*)(ws + WS_MODP); float* mod = (float*)(ws + WS_MOD);
    const int tb = F.vcu * 128 + F.wave * 4; const float* X = a.in[I_X];
    f32x4 va[4][4], vb[4][4];
    if (F.wave != 7) { p1_load(va, X, tb, F.lane); p1_load(vb, X, tb + 32, F.lane); }
    CFENCE();
    if (F.tid == 448) { unsigned* ctlw = (unsigned*)(ws + WS_CTL); XB_SPIN(xb_ld(ctlw + CW_ADA) < (unsigned)F.G, ctlw + CW_BAR); __builtin_amdgcn_fence(__ATOMIC_ACQUIRE, "agent"); asm volatile("s_waitcnt vmcnt(0)" ::: "memory"); }
    __syncthreads();
    LAS float* sh = (LAS float*)F.lds; const int b = F.vcu >> 5;
    {   float pv[4][9];
#pragma unroll
        for (int q = 0; q < 4; ++q) { const int j = F.tid + 512 * q; pv[q][8] = a.in[I_BADA][j];
#pragma unroll
            for (int kc = 0; kc < 8; ++kc) pv[q][kc] = modp[(size_t)(kc * 8 + b) * 6144 + j]; }
        CFENCE(); if (F.wave == 7) { p1_load(va, X, tb, F.lane); p1_load(vb, X, tb + 32, F.lane); } CFENCE();
        if (F.tid < 192) { const int i = F.vcu * 192 + F.tid, bb = i / 6144, j = i % 6144; float s = a.in[I_BADA][j];
#pragma unroll
            for (int kc = 0; kc < 8; ++kc) s += modp[(size_t)(kc * 8 + bb) * 6144 + j];
            mod[i] = s; }
        __syncthreads();
#pragma unroll
        for (int q = 0; q < 4; ++q) { float s = pv[q][8];
#pragma unroll
            for (int kc = 0; kc < 8; ++kc) s += pv[q][kc];
            sh[F.tid + 512 * q] = s; } }
    __syncthreads();
    unsigned char* U8 = ws + WS_U;
    CFENCE(); p1_proc(va, U8, sh, tb, F.lane); CFENCE(); p1_load(va, X, tb + 64, F.lane); CFENCE();
    p1_proc(vb, U8, sh, tb + 32, F.lane); CFENCE(); p1_load(vb, X, tb + 96, F.lane); CFENCE();
    p1_proc(va, U8, sh, tb + 64, F.lane); CFENCE();
    p1_proc(vb, U8, sh, tb + 96, F.lane);
    __syncthreads();
}

__device__ __forceinline__ void s5_scan(const Frame& F, const Args& a) {
    unsigned char* ws = a.ws; const bf16_t* Sg = (const bf16_t*)(ws + WS_S); bf16_t* UX = (bf16_t*)(ws + WS_UX);
    LAS float* xs = (LAS float*)F.lds;
    const int set = F.wave >> 2, seg = F.wave & 3, p = F.lane;
    for (int it = 0; it * F.G * 2 < NGRP * NB * 2; ++it) {
        const int trip = (it * F.G + F.vcu) * 2 + set; const bool live = trip < NGRP * NB * 2;
        const int g = trip >> 4, b = (trip >> 1) & 7, d = trip & 1;
        unsigned sp[64];
        float Ar = 0.f, Ai = 0.f;
        if (live) {
            const float lr = a.in[I_LRE][(d * NGRP + g) * 64 + p], li = a.in[I_LIM][(d * NGRP + g) * 64 + p], ldt = a.in[I_LDT][d * NGRP + g];
            const bf16_t* base = Sg + ((size_t)g * 2048 + b * 256) * 256 + d * 128 + p;
#pragma unroll
            for (int q = 0; q < 64; ++q) { const int c = d == 0 ? seg * 64 + q : 255 - (seg * 64 + q); sp[q] = (unsigned)(unsigned short)base[(size_t)c * 256] | ((unsigned)(unsigned short)base[(size_t)c * 256 + 64] << 16); }
            const float dt = expf(ldt), mg = expf(lr * dt * 16.f); float sn, cs; sincosf(li * dt * 16.f, &sn, &cs); Ar = mg * cs; Ai = mg * sn;
        } else {
#pragma unroll
            for (int q = 0; q < 64; ++q) sp[q] = 0u;
        }
        float lr_ = 0.f, li_ = 0.f;
#pragma unroll
        for (int q = 0; q < 64; ++q) { const float nr = Ar * lr_ - Ai * li_ + bf_lo(sp[q]), ni = Ar * li_ + Ai * lr_ + bf_hi(sp[q]); lr_ = nr; li_ = ni; }
        __syncthreads();
        xs[((set * 4 + seg) * 64 + p) * 2] = lr_; xs[((set * 4 + seg) * 64 + p) * 2 + 1] = li_;
        __syncthreads();
        float Pr = Ar, Pi = Ai;
#pragma unroll
        for (int s = 0; s < 6; ++s) { const float nr = Pr * Pr - Pi * Pi, ni = 2.f * Pr * Pi; Pr = nr; Pi = ni; }
        float cr_ = 0.f, ci_ = 0.f;
        for (int s = 0; s < seg; ++s) { const float tr = xs[((set * 4 + s) * 64 + p) * 2], ti = xs[((set * 4 + s) * 64 + p) * 2 + 1];
            const float nr = Pr * cr_ - Pi * ci_ + tr, ni = Pr * ci_ + Pi * cr_ + ti; cr_ = nr; ci_ = ni; }
        if (live) {
            bf16_t* ob = UX + ((size_t)g * 2048 + b * 256) * 512 + 256 + d * 128 + p;
#pragma unroll
            for (int q = 0; q < 64; ++q) { const int c = d == 0 ? seg * 64 + q : 255 - (seg * 64 + q);
                ob[(size_t)c * 512] = (bf16_t)(cvt_pk_bf16(cr_, 0.f) & 0xffffu); ob[(size_t)c * 512 + 64] = (bf16_t)(cvt_pk_bf16(ci_, 0.f) & 0xffffu);
                const float nr = Ar * cr_ - Ai * ci_ + bf_lo(sp[q]), ni = Ar * ci_ + Ai * cr_ + bf_hi(sp[q]); cr_ = nr; ci_ = ni; }
        }
        __syncthreads();
    }
}

typedef float f32x16 __attribute__((ext_vector_type(16)));
__device__ __forceinline__ void fourier_stage1(const Frame& F, const Args& a) {
    const bf16_t* UFT = (const bf16_t*)(a.ws + WS_UFT); bf16_t* YT = (bf16_t*)(a.ws + WS_YT);
    const int r = F.lane & 31, h = F.lane >> 5, k1 = r & 15, yp = r >> 4;
    float av[8];
#pragma unroll
    for (int j = 0; j < 8; ++j) { const float x = (float)((k1 * (8 * h + j)) & 15) * 0.125f; av[j] = yp == 0 ? cospif(x) : -sinpif(x); }
    const u32x4 au = {cvt_pk_bf16(av[0], av[1]), cvt_pk_bf16(av[2], av[3]), cvt_pk_bf16(av[4], av[5]), cvt_pk_bf16(av[6], av[7])};
    const bf16x8 af = __builtin_bit_cast(bf16x8, au);
    const int gw = F.vcu * 8 + F.wave, NGW = F.G * 8;
    LAS bf16_t* tile = (LAS bf16_t*)(F.lds + F.wave * 8192);
    constexpr int NST1 = NB * 512 * 2;
    auto ld = [&](unsigned short (&x)[32], int st) { const int q4 = st & 1, ch = (st >> 1) & 511, b = st >> 10;
#pragma unroll
        for (int q = 0; q < 4; ++q) { const bf16_t* src = UFT + (size_t)ch * TOK + b * SEQ + 256 * (8 * h) + 128 * q4 + 32 * q + r;
#pragma unroll
            for (int j = 0; j < 8; ++j) x[q * 8 + j] = (unsigned short)src[256 * j]; } };
    auto proc = [&](const unsigned short (&x)[32], int st) { const int q4 = st & 1, ch = (st >> 1) & 511, b = st >> 10;
#pragma unroll
        for (int q = 0; q < 4; ++q) { f32x16 c; bf16x8 xb;
#pragma unroll
            for (int j = 0; j < 8; ++j) xb[j] = (short)x[q * 8 + j];
#pragma unroll
            for (int i = 0; i < 16; ++i) c[i] = 0.f;
            c = __builtin_amdgcn_mfma_f32_32x32x16_bf16(af, xb, c, 0, 0, 0);
#pragma unroll
            for (int i = 0; i < 16; ++i) { const int m = (i & 3) + 8 * (i >> 2) + 4 * h; tile[m * 128 + 32 * q + r] = (bf16_t)(cvt_pk_bf16(c[i], 0.f) & 0xffffu); } }
        LDS_WAIT(); asm volatile("" ::: "memory");
#pragma unroll
        for (int p = 0; p < 8; ++p) { const int chunk = p * 64 + F.lane, m = chunk >> 4, cc = chunk & 15;
            const u32x4 v = *(const LAS u32x4*)(tile + m * 128 + cc * 8);
            st16_wt(YT + ((size_t)(b * 16 + (m & 15)) * 512 + ch) * 512 + (m >> 4) * 256 + 128 * q4 + cc * 8, __builtin_bit_cast(f32x4, v)); }
        LDS_WAIT(); asm volatile("" ::: "memory"); };
    unsigned short xa[32], xc[32];
    if (gw < NST1) ld(xa, gw);
    for (int st = gw; st < NST1; st += 2 * NGW) {
        CFENCE(); if (st + NGW < NST1) ld(xc, st + NGW); CFENCE();
        proc(xa, st);
        CFENCE(); if (st + 2 * NGW < NST1) ld(xa, st + 2 * NGW); CFENCE();
        if (st + NGW < NST1) proc(xc, st + NGW);
    }
}
struct SchedDft2 : SchedDense {
    __device__ __forceinline__ const char* a_base(const Unit& u) const { return A + (size_t)(u.z & 15) * zA + (size_t)u.pm * 256 * lda; }
};
struct EpiZc2 { unsigned char* ZC;
    __device__ __forceinline__ void operator()(AccRef acc, const Unit& u, int wr, int wc, int fr, int fq) const {
#pragma unroll
        for (int bj = 0; bj < 2; ++bj) { const int c = u.pm * 512 + 256 * u.pn + EPI_COL_L(bj);
#pragma unroll
            EPI_ROWS { const int t = (u.z >> 4) * SEQ + (u.z & 15) + 16 * EPI_ROW_L;
                *(u32x2*)(ZC + (size_t)t * 1024 + c) = (u32x2){pk4_fp8(acc[ai][bj][m][0], ZC_SCALE), pk4_fp8(acc[ai][bj][m][1], ZC_SCALE)}; } }
    } };

__device__ __forceinline__ void p8_load(u32x4 (&w)[4][2], const bf16_t* R1, const int t0, const int lane) {
#pragma unroll
    for (int q = 0; q < 4; ++q)
#pragma unroll
        for (int j = 0; j < 2; ++j) w[q][j] = *(const u32x4*)(R1 + (size_t)(t0 + q) * 1024 + 8 * lane + 512 * j);
}
__device__ __forceinline__ void p8_proc(u32x4 (&w)[4][2], bf16_t* X1, bf16_t* H, unsigned char* H8, const LAS f32x4* cst, const int t0, const int lane) {
#pragma unroll
    for (int q = 0; q < 4; ++q) { const int t = t0 + q; f32x4 v[4]; float s = 0.f;
#pragma unroll
        for (int j = 0; j < 2; ++j) { unpack8(w[q][j], v[2 * j], v[2 * j + 1]); s += (v[2 * j].x + v[2 * j].y) + (v[2 * j].z + v[2 * j].w) + (v[2 * j + 1].x + v[2 * j + 1].y) + (v[2 * j + 1].z + v[2 * j + 1].w); }
        float mean = wave_sum(s) * (1.f / 1024.f), s2 = 0.f;
#pragma unroll
        for (int j = 0; j < 4; ++j) { v[j] = v[j] - mean; s2 += (v[j].x * v[j].x + v[j].y * v[j].y) + (v[j].z * v[j].z + v[j].w * v[j].w); }
        float rstd = 1.f / sqrtf(wave_sum(s2) * (1.f / 1024.f) + LN_EPS);
        s = 0.f;
#pragma unroll
        for (int j = 0; j < 4; ++j) { v[j] = v[j] * rstd * cst[(0 * 4 + j) * 64 + lane] + cst[(1 * 4 + j) * 64 + lane]; s += (v[j].x + v[j].y) + (v[j].z + v[j].w); }
        mean = wave_sum(s) * (1.f / 1024.f); s2 = 0.f;
#pragma unroll
        for (int j = 0; j < 4; ++j) { v[j] = v[j] - mean; s2 += (v[j].x * v[j].x + v[j].y * v[j].y) + (v[j].z * v[j].z + v[j].w * v[j].w); }
        rstd = 1.f / sqrtf(wave_sum(s2) * (1.f / 1024.f) + LN_EPS);
#pragma unroll
        for (int j = 0; j < 4; ++j) v[j] = v[j] * rstd * cst[(3 * 4 + j) * 64 + lane] + cst[(2 * 4 + j) * 64 + lane];
#pragma unroll
        for (int j = 0; j < 2; ++j) { *(u32x4*)(H + (size_t)t * 1024 + 8 * lane + 512 * j) = pack8(v[2 * j], v[2 * j + 1]);
            *(u32x2*)(H8 + (size_t)t * 1024 + 8 * lane + 512 * j) = (u32x2){pk4_fp8(v[2 * j], H_SCALE), pk4_fp8(v[2 * j + 1], H_SCALE)}; } }
}
__device__ __forceinline__ void p8_ln1(const Frame& F, const Args& a) {
    unsigned char* ws = a.ws; const bf16_t* R1 = (const bf16_t*)(ws + WS_R1); bf16_t* X1 = (bf16_t*)(ws + WS_X1); bf16_t* H = (bf16_t*)(ws + WS_H); unsigned char* H8 = ws + WS_H8; const float* mod = (const float*)(ws + WS_MOD);
    const int b = F.vcu >> 5, tb = F.vcu * 128 + F.wave * 4;
    u32x4 wa[4][2], wb[4][2], wc[4][2];
    f32x4 k0, k1, k2, k3; { const int j = (F.tid >> 6) & 3, l = F.tid & 63, c = 8 * l + 512 * (j >> 1) + 4 * (j & 1);
        k0 = *(const f32x4*)(a.in[I_LN1G] + c); k1 = *(const f32x4*)(a.in[I_LN1B] + c); k2 = *(const f32x4*)(mod + b * 6144 + 3072 + c); k3 = *(const f32x4*)(mod + b * 6144 + 4096 + c); }
    CFENCE();
    p8_load(wa, R1, tb, F.lane); p8_load(wb, R1, tb + 32, F.lane); p8_load(wc, R1, tb + 64, F.lane); CFENCE();
    LAS f32x4* cst = (LAS f32x4*)F.lds;
    __syncthreads();
    if (F.tid < 256) { const int j = F.tid >> 6, l = F.tid & 63;
        cst[(0 * 4 + j) * 64 + l] = k0; cst[(1 * 4 + j) * 64 + l] = k1; cst[(2 * 4 + j) * 64 + l] = k2; cst[(3 * 4 + j) * 64 + l] = k3 + 1.f; }
    __syncthreads();
    CFENCE(); p8_proc(wa, X1, H, H8, cst, tb, F.lane); CFENCE(); p8_load(wa, R1, tb + 96, F.lane); CFENCE();
    p8_proc(wb, X1, H, H8, cst, tb + 32, F.lane); CFENCE();
    p8_proc(wc, X1, H, H8, cst, tb + 64, F.lane); CFENCE();
    p8_proc(wa, X1, H, H8, cst, tb + 96, F.lane);
    __syncthreads();
}

__device__ __forceinline__ void p10_route(const Frame& F, const Args& a, const bool have_sel) {
    unsigned char* ws = a.ws; const float* LG = (const float*)(ws + WS_LOGITS); int* eidx = (int*)(ws + WS_EIDX); float* gatev = (float*)(ws + WS_GATE);
    LAS float* sel = (LAS float*)F.lds;
    LAS int* le = (LAS int*)(F.lds + LDSCTL_OFF + 2048);
    const float* rb = a.in[I_RBIAS];
    __syncthreads();
    if (!have_sel) {   f32x4 lgv[16]; const f32x4 bb = *(const f32x4*)(rb + (F.tid & 63) * 4);
#pragma unroll
        for (int k = 0; k < 16; ++k) lgv[k] = *(const f32x4*)(LG + (size_t)(F.vcu * 128 + (F.tid >> 6) + 8 * k) * 256 + (F.tid & 63) * 4);
#pragma unroll
        for (int k = 0; k < 16; ++k) { const int r = (F.tid >> 6) + 8 * k, e0 = (F.tid & 63) * 4; const f32x4 lg = lgv[k];
            sel[r * 256 + ((e0 + 0 + r) & 255)] = sigm(lg.x) + bb.x; sel[r * 256 + ((e0 + 1 + r) & 255)] = sigm(lg.y) + bb.y;
            sel[r * 256 + ((e0 + 2 + r) & 255)] = sigm(lg.z) + bb.z; sel[r * 256 + ((e0 + 3 + r) & 255)] = sigm(lg.w) + bb.w; } }
    __syncthreads();
    LAS int* hist = le + 1024;
    if (F.tid < NEXP) hist[F.tid] = 0;
    {
        const int r = F.tid >> 2, prt = F.tid & 3, t = F.vcu * 128 + r, lb = F.lane & ~3; const LAS float* row = sel + r * 256;
        float gl[2];
#pragma unroll
        for (int g2 = 0; g2 < 2; ++g2) { const int gi = prt * 2 + g2; float m1 = -INFINITY, m2 = -INFINITY;
#pragma unroll
            for (int j0 = 0; j0 < 32; j0 += 8) { float cv[8];
#pragma unroll
                for (int k = 0; k < 8; ++k) cv[k] = row[(gi * 32 + ((j0 + k + 8 * prt) & 31) + r) & 255];
#pragma unroll
                for (int k = 0; k < 8; ++k) { const float v = cv[k]; const float n2 = fmaxf(m2, fminf(m1, v)); m1 = fmaxf(m1, v); m2 = n2; } }
            gl[g2] = m1 + m2; }
        (void)lb;
        const float gs[8] = {dpp_f<0x00>(gl[0]), dpp_f<0x00>(gl[1]), dpp_f<0x55>(gl[0]), dpp_f<0x55>(gl[1]), dpp_f<0xAA>(gl[0]), dpp_f<0xAA>(gl[1]), dpp_f<0xFF>(gl[0]), dpp_f<0xFF>(gl[1])};
        unsigned mask = 0u;
#pragma unroll
        for (int s4 = 0; s4 < 4; ++s4) { float best = -INFINITY; int bi = 0;
#pragma unroll
            for (int gi = 0; gi < 8; ++gi) { const bool ok = !((mask >> gi) & 1u) && (gs[gi] > best); best = ok ? gs[gi] : best; bi = ok ? gi : bi; }
            mask |= 1u << bi; }
        float bv[8]; int be[8];
#pragma unroll
        for (int q = 0; q < 8; ++q) { bv[q] = -INFINITY; be[q] = 0x7fffffff; }
#define TOPK_INSERT(v_, e_) do { float v = (v_); int e = (e_); _Pragma("unroll") for (int q = 0; q < 8; ++q) { const bool gt = v > bv[q]; \
            const float tv = bv[q]; const int te = be[q]; bv[q] = gt ? v : tv; be[q] = gt ? e : te; v = gt ? tv : v; e = gt ? te : e; } } while (0)
        {
            int gsel = 0, left = prt;
#pragma unroll
            for (int gi = 0; gi < 8; ++gi) { const bool on = (mask >> gi) & 1u; gsel = (on && left == 0) ? gi : gsel; left -= on ? 1 : 0; }
#pragma unroll
            for (int j0 = 0; j0 < 32; j0 += 8) { float cv[8];
#pragma unroll
                for (int k = 0; k < 8; ++k) cv[k] = row[(gsel * 32 + j0 + k + r) & 255];
#pragma unroll
                for (int k = 0; k < 8; ++k) TOPK_INSERT(cv[k], gsel * 32 + j0 + k); } }
#define TOPK_GT(av, ae, bv_, be_) (((av) > (bv_)) || ((av) == (bv_) && (ae) < (be_)))
#define TOPK_CX(i, j) do { const bool sw = TOPK_GT(bv[j], be[j], bv[i], be[i]); const float tv = bv[i]; const int te = be[i]; bv[i] = sw ? bv[j] : tv; be[i] = sw ? be[j] : te; bv[j] = sw ? tv : bv[j]; be[j] = sw ? te : be[j]; } while (0)
#define TOPK_MERGE(CTRL) do { float ov[8]; int oe[8]; \
            _Pragma("unroll") for (int q = 0; q < 8; ++q) { ov[q] = dpp_f<CTRL>(bv[7 - q]); oe[q] = dpp_i<CTRL>(be[7 - q]); }        \
            _Pragma("unroll") for (int q = 0; q < 8; ++q) { const bool sw = TOPK_GT(ov[q], oe[q], bv[q], be[q]); bv[q] = sw ? ov[q] : bv[q]; be[q] = sw ? oe[q] : be[q]; } \
            TOPK_CX(0, 4); TOPK_CX(1, 5); TOPK_CX(2, 6); TOPK_CX(3, 7); \
            TOPK_CX(0, 2); TOPK_CX(1, 3); TOPK_CX(4, 6); TOPK_CX(5, 7); \
            TOPK_CX(0, 1); TOPK_CX(2, 3); TOPK_CX(4, 5); TOPK_CX(6, 7); } while (0)
        TOPK_MERGE(0xB1);
        TOPK_MERGE(0x4E);
#undef TOPK_MERGE
#undef TOPK_CX
#undef TOPK_GT
#undef TOPK_INSERT
        float sc[8], sum = 0.f;
#pragma unroll
        for (int q = 0; q < 8; ++q) { sc[q] = bv[q] - rb[be[q]]; sum += sc[q]; }
        const float inv = 2.5f / sum;
        int* lrank = (int*)(ws + WS_LRANK);
        __syncthreads();
#pragma unroll
        for (int q = 0; q < 8; ++q) if ((q >> 1) == prt) { const int slot = t * 8 + q; eidx[slot] = be[q]; gatev[slot] = sc[q] * inv; lrank[slot] = __hip_atomic_fetch_add(&hist[be[q]], 1, __ATOMIC_RELAXED, __HIP_MEMORY_SCOPE_WORKGROUP); }
    }
    __syncthreads();
    if (F.tid < NEXP) ((int*)(ws + WS_CNTWG))[F.vcu * NEXP + F.tid] = hist[F.tid];
    __syncthreads();
}
__device__ __forceinline__ int expert_prefix(const Frame& F, const Args& a) {
    const unsigned* cnt = (const unsigned*)(a.ws + WS_CTL) + CW_CNT; LAS int* ps = (LAS int*)(F.lds + LDS_PS_OFF);
    __syncthreads();
    if (F.tid < 64) { int v[4], s = 0;
#pragma unroll
        for (int q = 0; q < 4; ++q) { v[q] = (int)((cnt[F.tid * 4 + q] + 255u) & ~255u); s += v[q]; }
        int inc = s;
#pragma unroll
        for (int o = 1; o < 64; o <<= 1) { const int n = __shfl_up(inc, o); if (F.tid >= o) inc += n; }
        int run = inc - s;
#pragma unroll
        for (int q = 0; q < 4; ++q) { ps[F.tid * 4 + q] = run; run += v[q]; }
        if (F.tid == 63) ps[256] = run; }
    __syncthreads();
    return ps[256] >> 8;
}
__device__ __forceinline__ void p11_place(const Frame& F, const Args& a) {
    unsigned char* ws = a.ws; const int* eidx = (const int*)(ws + WS_EIDX); const float* gatev = (const float*)(ws + WS_GATE);
    unsigned* cnt = (unsigned*)(ws + WS_CTL) + CW_CNT; const int* cntwg = (const int*)(ws + WS_CNTWG); const int* lrank = (const int*)(ws + WS_LRANK);
    int* row_slot = (int*)(ws + WS_ROWSLOT);
    LAS int* ps = (LAS int*)(F.lds + LDS_PS_OFF); LAS int* off = (LAS int*)(F.lds + LDSCTL_OFF + 2048); LAS int* tot = off + 256;
    __syncthreads();
    {
        const int e = F.tid & 255, hf = F.tid >> 8; int o = 0, t = 0;
#pragma unroll
        for (int w0 = 0; w0 < 128; w0 += 64) { int v[64];
#pragma unroll
            for (int k = 0; k < 64; ++k) v[k] = cntwg[(128 * hf + w0 + k) * NEXP + e];
#pragma unroll
            for (int k = 0; k < 64; ++k) { t += v[k]; o += (128 * hf + w0 + k < F.vcu) ? v[k] : 0; } }
        LAS int* part = tot + 256;
        if (hf == 1) { part[e] = o; part[256 + e] = t; }
        __syncthreads();
        if (hf == 0) { o += part[e]; t += part[256 + e]; off[e] = o; tot[e] = t; if (F.vcu == 0) cnt[e] = (unsigned)t; } }
    __syncthreads();
    if (F.tid < 64) { int v[4], sm = 0;
#pragma unroll
        for (int q = 0; q < 4; ++q) { v[q] = (tot[F.tid * 4 + q] + 255) & ~255; sm += v[q]; }
        int inc = sm;
#pragma unroll
        for (int o = 1; o < 64; o <<= 1) { const int n = __shfl_up(inc, o); if (F.tid >= o) inc += n; }
        int run = inc - sm;
#pragma unroll
        for (int q = 0; q < 4; ++q) { ps[F.tid * 4 + q] = run; run += v[q]; }
        if (F.tid == 63) ps[256] = run; }
    __syncthreads();
    {   int ev[2], lv[2]; float gv2[2];
#pragma unroll
        for (int k = 0; k < 2; ++k) { const int slot = F.vcu * 1024 + F.tid + 512 * k; ev[k] = eidx[slot]; lv[k] = lrank[slot]; gv2[k] = gatev[slot]; }
#pragma unroll
        for (int k = 0; k < 2; ++k) { const int slot = F.vcu * 1024 + F.tid + 512 * k; const int pos = ps[ev[k]] + off[ev[k]] + lv[k];
            row_slot[pos] = (int)((unsigned)slot | ((unsigned)(gv2[k] * 3000.f + 0.5f) << 19)); } }
    { const int e = F.vcu; const int lo = ps[e] + tot[e], hi = ps[e + 1];
        for (int pos = lo + F.tid; pos < hi; pos += 512) row_slot[pos] = 0x7FFFF; }
    __syncthreads();
}

__device__ __forceinline__ void p14_load(u32x4 (&ys)[2][9], u32x2 (&xs)[2][4], const unsigned char* YS, const bf16_t* X1, const int t0, const int c0) {
#pragma unroll
    for (int q = 0; q < 2; ++q) { const int t = t0 + q;
#pragma unroll
        for (int k = 0; k < 8; ++k) ys[q][k] = *(const u32x4*)(YS + (size_t)(t * 8 + k) * 1024 + c0);
        ys[q][8] = *(const u32x4*)(YS + (size_t)(TOK * TOPK + t) * 1024 + c0);
#pragma unroll
        for (int j = 0; j < 4; ++j) xs[q][j] = *(const u32x2*)(X1 + (size_t)t * 1024 + (c0 >> 2) + 256 * j); }
}
__device__ __forceinline__ void p14_proc(u32x4 (&ys)[2][9], u32x2 (&xs)[2][4], float* out, const LAS f32x4* cst, const int t0, const int lane) {
    typedef float f2_t __attribute__((ext_vector_type(2)));
    const int c0 = 4 * lane;
#pragma unroll
    for (int q = 0; q < 2; ++q) { const int t = t0 + q; f32x4 v[4], y[4];
#pragma unroll
        for (int j = 0; j < 4; ++j) { v[j] = (f32x4){bf_lo(xs[q][j].x), bf_hi(xs[q][j].x), bf_lo(xs[q][j].y), bf_hi(xs[q][j].y)}; y[j] = (f32x4){0.f, 0.f, 0.f, 0.f}; }
        {   float s1 = 0.f;
#pragma unroll
            for (int j = 0; j < 4; ++j) s1 += (v[j].x + v[j].y) + (v[j].z + v[j].w);
            const float mean1 = wave_sum(s1) * (1.f / 1024.f); float q1 = 0.f;
#pragma unroll
            for (int j = 0; j < 4; ++j) { v[j] = v[j] - mean1; q1 += (v[j].x * v[j].x + v[j].y * v[j].y) + (v[j].z * v[j].z + v[j].w * v[j].w); }
            const float rstd1 = 1.f / sqrtf(wave_sum(q1) * (1.f / 1024.f) + LN_EPS);
#pragma unroll
            for (int j = 0; j < 4; ++j) v[j] = v[j] * rstd1 * cst[(3 * 4 + j) * 64 + lane] + cst[(4 * 4 + j) * 64 + lane]; }
#pragma unroll
        for (int k = 0; k < 9; ++k) {
#pragma unroll
            for (int j = 0; j < 4; ++j) { const int w = (int)ys[q][k][j]; const f2_t lo = __builtin_amdgcn_cvt_pk_f32_fp8(w, false), hi = __builtin_amdgcn_cvt_pk_f32_fp8(w, true);
                y[j] += (f32x4){lo.x, lo.y, hi.x, hi.y}; } }
        float s = 0.f;
#pragma unroll
        for (int j = 0; j < 4; ++j) { v[j] = v[j] * ALPHA + cst[(0 * 4 + j) * 64 + lane] * (y[j] * (1.f / YS_SCALE)); s += (v[j].x + v[j].y) + (v[j].z + v[j].w); }
        const float mean = wave_sum(s) * (1.f / 1024.f); float s2 = 0.f;
#pragma unroll
        for (int j = 0; j < 4; ++j) { v[j] = v[j] - mean; s2 += (v[j].x * v[j].x + v[j].y * v[j].y) + (v[j].z * v[j].z + v[j].w * v[j].w); }
        const float rstd = 1.f / sqrtf(wave_sum(s2) * (1.f / 1024.f) + LN_EPS);
#pragma unroll
        for (int j = 0; j < 4; ++j) *(f32x4*)(out + (size_t)t * 1024 + c0 + 256 * j) = v[j] * rstd * cst[(1 * 4 + j) * 64 + lane] + cst[(2 * 4 + j) * 64 + lane]; }
}
__device__ __forceinline__ void p14_final(const Frame& F, const Args& a) {
    unsigned char* ws = a.ws; const bf16_t* X1 = (const bf16_t*)(ws + WS_R1); const unsigned char* YS = ws + WS_YSLOT; const float* mod = (const float*)(ws + WS_MOD);
    const int b = F.vcu >> 5, c0 = 16 * F.lane, tb = F.vcu * 128 + F.wave * 2;
    u32x4 ya[2][9], yb[2][9]; u32x2 xa[2][4], xb[2][4];
    f32x4 k0, k1, k2, k3, k4; { const int j = (F.tid >> 6) & 3, l = F.tid & 63, c = 4 * l + 256 * j;
        k0 = *(const f32x4*)(mod + b * 6144 + 5120 + c); k1 = *(const f32x4*)(a.in[I_LN2G] + c); k2 = *(const f32x4*)(a.in[I_LN2B] + c); k3 = *(const f32x4*)(a.in[I_LN1G] + c); k4 = *(const f32x4*)(a.in[I_LN1B] + c); }
    CFENCE();
    p14_load(ya, xa, YS, X1, tb, c0); p14_load(yb, xb, YS, X1, tb + 16, c0); CFENCE();
    LAS f32x4* cst = (LAS f32x4*)F.lds;
    __syncthreads();
    if (F.tid < 256) { const int j = F.tid >> 6, l = F.tid & 63;
        cst[(0 * 4 + j) * 64 + l] = k0; cst[(1 * 4 + j) * 64 + l] = k1; cst[(2 * 4 + j) * 64 + l] = k2; cst[(3 * 4 + j) * 64 + l] = k3; cst[(4 * 4 + j) * 64 + l] = k4; }
    __syncthreads();
    CFENCE();
#pragma unroll 1
    for (int i = 0; i < 3; ++i) { const int t0 = tb + 32 * i;
        p14_proc(ya, xa, a.out, cst, t0, F.lane); CFENCE(); p14_load(ya, xa, YS, X1, t0 + 32, c0); CFENCE();
        p14_proc(yb, xb, a.out, cst, t0 + 16, F.lane); CFENCE(); p14_load(yb, xb, YS, X1, t0 + 48, c0); CFENCE(); }
    p14_proc(ya, xa, a.out, cst, tb + 96, F.lane); CFENCE();
    p14_proc(yb, xb, a.out, cst, tb + 112, F.lane);
}

constexpr int N_PHASES = 15;

__global__ void __launch_bounds__(512, 2) fwd_kernel(Args a) {
    extern __shared__ __attribute__((aligned(16))) unsigned char lds_raw[];
    Frame F; F.lds = (LAS unsigned char*)lds_raw; F.tid = threadIdx.x; F.lane = F.tid & 63; F.wave = __builtin_amdgcn_readfirstlane(F.tid >> 6);
    F.G = gridDim.x; { const int bx = blockIdx.x; F.vcu = (F.G % 8 == 0) ? (bx % 8) * (F.G / 8) + bx / 8 : bx; }
    unsigned char* ws = a.ws;
    unsigned* ctl = (unsigned*)(ws + WS_CTL);
    for (int u = F.tid; u < (LDS_BYTES - LDSCTL_OFF) / 4; u += 512) ((LAS unsigned*)(F.lds + LDSCTL_OFF))[u] = 0u;
    __syncthreads();
    __builtin_amdgcn_s_setreg(1473, 1u);
    const int lo = a.ph_lo, hi = a.ph_hi;
    XcdBarrier bar; bar.bar = ctl + CW_BAR; bar.x = 0; bar.st = nullptr;
    if (hi - lo > 1) bar = xcd_barrier_post(ctl + CW_BAR, (volatile LAS unsigned*)(F.lds + LDSCTL_OFF));
#ifndef PHASE_MASK
#define PHASE_MASK 0x7fff
#endif
#define IN(k) (((PHASE_MASK >> (k)) & 1) && lo <= (k) && (k) < hi)
#define SEAM(k) do { if (IN(k) && IN((k) + 1)) xcd_barrier(bar); } while (0)
    LAS unsigned char* ring = F.lds;
    const int G = F.G, c = F.vcu;

    if (IN(0)) { p0_prologue(F, a); }
    if (IN(1)) { p1_modulate(F, a); } SEAM(1);
    if (IN(2)) {
        LAS float* lbin = (LAS float*)(F.lds + LDS_TAB_OFF);
        {   float bv[6];
#pragma unroll
            for (int k = 0; k < 6; ++k) bv[k] = a.in[I_BIN][F.tid + 512 * k];
#pragma unroll
            for (int k = 0; k < 6; ++k) lbin[F.tid + 512 * k] = bv[k]; }
        __syncthreads();
        { SchedInProj S; S.init(ws + WS_U, 1024, 0, ws + WS_WIN, 1024, 0, 128, 12, 1, 512, G, c);
          EpiInProj E{EpiS5U{(bf16_t*)(ws + WS_UX), lbin}, EpiFT{(bf16_t*)(ws + WS_UFT), lbin + 512}, EpiGate{ws + WS_GATES, lbin + 1024}, ctl + CW_P2}; pg8::gemm_phase<EpiInProj, SchedInProj, PG_ALIGN, PG_SP2, true>(ring, S, E); }
    }
    if (IN(3)) {
        if (IN(2)) {
            if (F.tid < 8) { XB_SPIN(xb_ld(ctl + CW_P2 + 16 * F.tid) < (unsigned)G, ctl + CW_BAR); __builtin_amdgcn_fence(__ATOMIC_ACQUIRE, "agent"); asm volatile("s_waitcnt vmcnt(0)" ::: "memory"); }
            __syncthreads(); }
        fourier_stage1(F, a);
        VM_WAIT(); __syncthreads();
        if (F.tid == 0) (void)xb_add(ctl + CW_YT, 1u);
        { SchedDense S; S.init(ws + WS_UX, 1024, (size_t)2048 * 1024, ws + WS_S5MB, 512, (size_t)256 * 512, 8, 1, NGRP, 256, G, c);
          EpiB16 E{(bf16_t*)(ws + WS_S), 256, (size_t)2048 * 256}; pg8::gemm_phase<EpiB16, SchedDense, PG_ALIGN, PG_SP2>(ring, S, E); }
        VM_WAIT(); __syncthreads();
        s5_scan(F, a);
        VM_WAIT(); __syncthreads();
    }
    if (IN(4)) {
        { SchedDense S; S.init(ws + WS_UX, 1024, (size_t)2048 * 1024, ws + WS_S5TC, 1024, (size_t)256 * 1024, 8, 1, NGRP, 512, G, c);
          EpiS5Y E{ws + WS_Z}; pg8::gemm_phase<EpiS5Y, SchedDense, PG_ALIGN, PG_SP2>(ring, S, E); }
        if (IN(3)) {
            if (F.tid == 0) { XB_SPIN(xb_ld(ctl + CW_YT) < (unsigned)G, ctl + CW_BAR); __builtin_amdgcn_fence(__ATOMIC_ACQUIRE, "agent"); asm volatile("s_waitcnt vmcnt(0)" ::: "memory"); }
            __syncthreads(); }
        { SchedDft2 S; S.init(ws + WS_DFT, 1024, (size_t)512 * 1024, ws + WS_YT, 1024, (size_t)512 * 1024, 2, 2, NB * 16, 512, G, c);
          EpiZc2 E{ws + WS_ZC}; pg8::gemm_phase<EpiZc2, SchedDft2, PG_ALIGN, PG_SP2>(ring, S, E); }
    }
    if (IN(5)) { } SEAM(5);
    if (IN(6)) {
        LAS float* lb6 = (LAS float*)(F.lds + LDS_TAB_OFF);
        {   float bv[6];
#pragma unroll
            for (int k = 0; k < 6; ++k) { const int q = F.tid + 512 * k; bv[k] = k < 4 ? a.in[I_BGLU][q] : a.in[I_BF][q - 2048]; }
#pragma unroll
            for (int k = 0; k < 6; ++k) lb6[F.tid + 512 * k] = bv[k]; }
        __syncthreads();
        { SchedPanel S; S.init(ws + WS_Z, 512, 0, ws + WS_WGLU, 512, 0, 128, 8, 1, 256, G, c); S.npc = 4; EpiGlu E{ws + WS_P, lb6}; pg8::gemm_phase<EpiGlu, SchedPanel, PG_ALIGN, PG_SP2, true>(ring, S, E); }
        VM_WAIT(); __syncthreads();
        { SchedPanel S; S.init(ws + WS_ZC, 1024, 0, ws + WS_WFP, 1024, 0, 128, 4, 1, 512, G, c); S.npc = 2; EpiMerge E{ws + WS_MERGED, ws + WS_P, ws + WS_GATES, lb6 + 2048}; pg8::gemm_phase<EpiMerge, SchedPanel, PG_ALIGN, PG_SP2, true>(ring, S, E); }
    } SEAM(6);
    if (IN(7)) {
        SchedDense S; S.init(ws + WS_MERGED, 1024, 0, ws + WS_WOUT, 1024, 0, 128, 4, 1, 512, G, c);
        EpiOut E{(bf16_t*)(ws + WS_R1), a.in[I_X], (const float*)(ws + WS_MOD), a.in[I_BOUT]}; pg8::gemm_phase<EpiOut, SchedDense, PG_ALIGN, PG_SP2, true>(ring, S, E);
    } SEAM(7);
    if (IN(8)) { p8_ln1(F, a); } SEAM(8);
    if (IN(9)) {
        unsigned* pflag = ctl + CW_PAIR + 16 * (c >> 1);
        if ((c & 1) == 0) { { SchedDense S; S.init(ws + WS_H, 2048, 0, ws + WS_WRT, 2048, 0, 128, 1, 1, 1024, G / 2, c >> 1); EpiRouter E{(float*)(ws + WS_LOGITS), (LAS float*)F.lds, a.in[I_RBIAS]}; pg8::gemm_phase<EpiRouter, SchedDense, PG_ALIGN, PG_SP2>(ring, S, E); }
            VM_WAIT(); __syncthreads();
            if (F.tid == 0) __hip_atomic_store(pflag, 1u, __ATOMIC_RELAXED, __HIP_MEMORY_SCOPE_AGENT);
        } else { { SchedDense S; S.init(ws + WS_H8, 1024, 0, ws + WS_WSHGU, 1024, 0, 128, 2, 1, 512, G / 2, c >> 1); EpiSwi8 E{ws + WS_HID, SH_TILE0 * 256, 1.f / (W_SCALE * H_SCALE)}; pg8::gemm_phase<EpiSwi8, SchedDense, PG_ALIGN, PG_SP2, true>(ring, S, E); }
            if (F.tid == 0) { XB_SPIN(xb_ld(pflag) == 0u, ctl + CW_BAR); __builtin_amdgcn_fence(__ATOMIC_ACQUIRE, "agent"); }
            __syncthreads();
        }
        p10_route(F, a, (c & 1) == 0);
    }
    if (IN(10)) { } SEAM(10);
    if (IN(11)) { p11_place(F, a); } SEAM(11);
    if (IN(12)) {
        const int ntiles = lo <= 11 ? __builtin_amdgcn_readfirstlane(((const LAS int*)(F.lds + LDS_PS_OFF))[256] >> 8) : expert_prefix(F, a);
        LAS int* ttok = (LAS int*)(F.lds + LDS_TAB_OFF);
        { const int* row_tok = (const int*)(ws + WS_ROWSLOT); const int per = (ntiles * 2 + G - 1) / G;
          int tk[5];
#pragma unroll
          for (int k = 0; k < 5; ++k) { const int q = F.tid + 512 * k, mt = ((q >> 8) * G + c) >> 1; const bool ok = q < per * 256 && mt < ntiles; const int v = row_tok[ok ? mt * 256 + (q & 255) : 0] & 0x7FFFF; tk[k] = (ok && v != 0x7FFFF) ? (v >> 3) : 0; }
#pragma unroll
          for (int k = 0; k < 5; ++k) { const int q = F.tid + 512 * k; if (q < per * 256) ttok[q] = tk[k]; }
          __syncthreads(); }
        SchedExp<2, true> S; S.A = (const char*)(ws + WS_H8); S.B = (const char*)(ws + WS_EGU); S.row_tok = ttok; S.ps = (const LAS int*)(F.lds + LDS_PS_OFF); S.uexp = (const LAS int*)(F.lds + LDS_UEXP_OFF);
        S.lda = 1024; S.ldb = 1024; S.eB = (size_t)512 * 1024; S.tB = (size_t)256 * 1024; S.ntiles = ntiles; S.nsh = 0; S.nt = 8; S.G = G; S.c = c; S.kstepA = 128; S.kstepB = 128; S.hstepA = 0; S.hstepB = (size_t)128 * 1024;
        S.fill_unit_experts((LAS int*)(F.lds + LDS_UEXP_OFF));
        EpiSwi8 E{ws + WS_HID, 0, 1.f / (W_SCALE * H_SCALE)}; pg8::gemm_phase<EpiSwi8, SchedExp<2, true>, PG_ALIGN, PG_SP2, true>(ring, S, E);
    } SEAM(12);
    if (IN(13)) {
        const int ntiles = lo <= 11 ? __builtin_amdgcn_readfirstlane(((const LAS int*)(F.lds + LDS_PS_OFF))[256] >> 8) : expert_prefix(F, a);
        LAS unsigned* tab = (LAS unsigned*)(F.lds + LDS_TAB_OFF);
        { const int* row_slot = (const int*)(ws + WS_ROWSLOT); const int per = ((ntiles + TOK / 256) * 4 + G - 1) / G;
          int sl[11];
#pragma unroll
          for (int k = 0; k < 11; ++k) { const int q = F.tid + 512 * k, tl = ((q >> 8) * G + c) >> 2; const int r = (q < per * 256 && tl < ntiles) ? tl * 256 + (q & 255) : 0; sl[k] = row_slot[r]; }
#pragma unroll
          for (int k = 0; k < 11; ++k) { const int q = F.tid + 512 * k, tl = ((q >> 8) * G + c) >> 2; unsigned w = (unsigned)(TOK * TOPK + TOK + c);
              if (tl < ntiles) { if (((unsigned)sl[k] & 0x7FFFFu) != 0x7FFFFu) w = (unsigned)sl[k]; }
              else if (tl < ntiles + TOK / 256) w = (unsigned)(TOK * TOPK + (tl - ntiles) * 256 + (q & 255)) | (3000u << 19);
              if (a.flags & 1) w = (unsigned)(TOK * TOPK + TOK + 256 + c * 256 + (q & 255)) | (3000u << 19);
              if (q < per * 256) tab[q] = w; }
          __syncthreads(); }
        SchedExp<4, false, true> S; S.A = (const char*)(ws + WS_HID); S.B = (const char*)(ws + WS_EDN); S.row_tok = nullptr; S.ps = (const LAS int*)(F.lds + LDS_PS_OFF); S.uexp = (const LAS int*)(F.lds + LDS_UEXP_OFF);
        S.lda = 256; S.ldb = 256; S.eB = (size_t)1024 * 256; S.tB = (size_t)64 * 256; S.ntiles = ntiles; S.nsh = TOK / 256; S.dbg = a.flags; S.nt = 2; S.G = G; S.c = c; S.kstepA = 128; S.kstepB = 128; S.hstepA = (size_t)128 * 256; S.hstepB = (size_t)128 * 256;
        S.fill_unit_experts((LAS int*)(F.lds + LDS_UEXP_OFF));
        EpiExDn E{ws + WS_YSLOT, tab, a.flags}; pg8::gemm_phase<EpiExDn, SchedExp<4, false, true>, PG_ALIGN, PG_SP2, true, P13_NT2 ? 8 : -1>(ring, S, E);
    } SEAM(13);
    if (IN(14)) { p14_final(F, a);
    }
#undef IN
#undef SEAM
}


extern "C" void kernel_launch(void* const* d_in, const int* in_sizes, int n_in, void* d_out, int out_size, void* d_ws, size_t ws_size, hipStream_t stream) {
    static int grid = 0;
    if (grid == 0) {
        if (n_in != 32 || in_sizes[0] != TOK * DM || out_size != TOK * DM || ws_size < WS_END) {
            fprintf(stderr, "kernel_launch: unexpected shapes (n_in %d, in0 %d, out %d, ws %zu, need %zu); nothing launched\n", n_in, n_in > 0 ? in_sizes[0] : -1, out_size, ws_size, (size_t)WS_END); grid = -1; return; }
        int dev = 0, cus = 0, per_cu = 0;
        if (hipGetDevice(&dev) != hipSuccess || hipDeviceGetAttribute(&cus, hipDeviceAttributeMultiprocessorCount, dev) != hipSuccess) { grid = -1; return; }
        if (hipFuncSetAttribute((const void*)fwd_kernel, hipFuncAttributeMaxDynamicSharedMemorySize, LDS_BYTES) != hipSuccess) { fprintf(stderr, "kernel_launch: hipFuncSetAttribute failed\n"); grid = -1; return; }
        if (hipOccupancyMaxActiveBlocksPerMultiprocessor(&per_cu, (const void*)fwd_kernel, 512, LDS_BYTES) != hipSuccess || per_cu < 1) { fprintf(stderr, "kernel_launch: occupancy query reports %d blocks per CU\n", per_cu); (void)hipGetLastError(); grid = -1; return; }
        grid = cus;
        if (grid != 256) { fprintf(stderr, "kernel_launch: built for a 256-CU device, found %d CUs\n", cus); grid = -1; return; }
    }
    if (grid < 0) return;
    if (hipMemsetAsync((char*)d_ws + WS_CTL, 0, CTL_ZERO_BYTES, stream) != hipSuccess) return;
    Args a{};
    for (int i = 0; i < 32; ++i) a.in[i] = (const float*)d_in[i];
    a.out = (float*)d_out; a.ws = (unsigned char*)d_ws;
#if MK_N_LAUNCHES == 1
    a.ph_lo = 0; a.ph_hi = N_PHASES;
    hipLaunchKernelGGL(fwd_kernel, dim3(grid), dim3(512), LDS_BYTES, stream, a);
#ifdef DBG_EXTRA_PHASE
    a.ph_lo = DBG_EXTRA_PHASE; a.ph_hi = DBG_EXTRA_PHASE + 1; a.flags = DBG_EXTRA_FLAGS;
    hipLaunchKernelGGL(fwd_kernel, dim3(grid), dim3(512), LDS_BYTES, stream, a);
#endif
#else
    for (int p = 0; p < N_PHASES; ++p) { a.ph_lo = p; a.ph_hi = p + 1; hipLaunchKernelGGL(fwd_kernel, dim3(grid), dim3(512), LDS_BYTES, stream, a); }
#endif
}
```
